# Optimizing an MI355X kernel written in HIP

```python
import jax, jax.numpy as jnp
from jax import lax
import numpy as np

D_MODEL = 1024
BATCH = 8
SEQ = 2048
DEPTH = 4

N_MEM = 256
N_MIXERS = 2
N_POOL_LAYERS = (DEPTH + 1) // 2
N_MOBA_LAYERS = DEPTH // 2
POOL_GROUPS = 4
POOL_WINDOWS = (2, 4, 8, 16)
POOL_GW = D_MODEL // POOL_GROUPS
MOBA_HEADS = 8
HEAD_DIM = D_MODEL // MOBA_HEADS
ROT_DIM = HEAD_DIM // 4
ROPE_THETA = 500000.0
MOBA_BLOCK = 256
MOBA_TOPK = 3
Q_CHUNK = 16
MEM_HEADS = 4
MEM_HEAD_DIM = D_MODEL // MEM_HEADS
D_FF = 4 * D_MODEL
RMS_EPS = 1e-6
N_NORMS = 6

kernel_name = "pool_moba_memory_hybrid_trunk"


def rms_norm(x, g):
    xf = x.astype(jnp.float32)
    y = xf * lax.rsqrt(jnp.mean(xf * xf, axis=-1, keepdims=True) + RMS_EPS)
    return (y * g.astype(jnp.float32)).astype(x.dtype)


def apply_partial_rope(x, cos, sin):
    half = ROT_DIM // 2
    xr = x[..., :ROT_DIM].astype(jnp.float32)
    x1, x2 = xr[..., :half], xr[..., half:]
    rot = jnp.concatenate([x1 * cos - x2 * sin, x2 * cos + x1 * sin], axis=-1)
    return jnp.concatenate([rot.astype(x.dtype), x[..., ROT_DIM:]], axis=-1)


def pool_mixer(h, w_in, w_group, scale):
    b, s, _ = h.shape
    u = (h @ w_in).reshape(b, s, POOL_GROUPS, POOL_GW)
    uf = u.astype(jnp.float32)
    cs = jnp.concatenate([jnp.zeros((b, 1, POOL_GROUPS, POOL_GW), jnp.float32),
                          jnp.cumsum(uf, axis=1)], axis=1)
    t = jnp.arange(s)
    outs = []
    for g, w in enumerate(POOL_WINDOWS):
        csg = cs[:, :, g]
        cs_lo = jnp.concatenate([jnp.zeros((b, w - 1, POOL_GW), jnp.float32), csg],
                                axis=1)[:, :s]
        win_sum = csg[:, 1:] - cs_lo
        cnt = jnp.minimum(t + 1, w).astype(jnp.float32)[None, :, None]
        outs.append(win_sum / cnt - uf[:, :, g])
    pooled = jnp.stack(outs, axis=2).astype(h.dtype)
    y = jnp.einsum('bsgc,gcd->bsgd', pooled, w_group).reshape(b, s, D_MODEL)
    return y * scale


def moba_attention(h, w_qkv, w_o, cos, sin):
    b, s, _ = h.shape
    qkv = (h @ w_qkv).reshape(b, s, 3, MOBA_HEADS, HEAD_DIM)
    q = jnp.transpose(qkv[:, :, 0], (0, 2, 1, 3))
    k = jnp.transpose(qkv[:, :, 1], (0, 2, 1, 3))
    v = jnp.transpose(qkv[:, :, 2], (0, 2, 1, 3))
    q = apply_partial_rope(q, cos, sin) * (HEAD_DIM ** -0.5)
    k = apply_partial_rope(k, cos, sin)
    n_blk = -(-s // MOBA_BLOCK)
    pad = n_blk * MOBA_BLOCK - s
    kb = jnp.pad(k, ((0, 0), (0, 0), (0, pad), (0, 0))).reshape(
        b, MOBA_HEADS, n_blk, MOBA_BLOCK, HEAD_DIM)
    vb = jnp.pad(v, ((0, 0), (0, 0), (0, pad), (0, 0))).reshape(
        b, MOBA_HEADS, n_blk, MOBA_BLOCK, HEAD_DIM)
    k_mean = jnp.mean(kb.astype(jnp.float32), axis=3)
    k_sel = min(MOBA_TOPK, n_blk)
    bi = jnp.arange(b)[:, None, None, None]
    hi = jnp.arange(MOBA_HEADS)[None, :, None, None]
    blk_ids = jnp.arange(n_blk)
    key_off = jnp.arange(MOBA_BLOCK)

    def chunk(c):
        start = c * Q_CHUNK
        qc = lax.dynamic_slice_in_dim(q, start, Q_CHUNK, axis=2)
        qpos = start + jnp.arange(Q_CHUNK)
        qblk = start // MOBA_BLOCK
        gate = jnp.einsum('bhqd,bhnd->bhqn', qc.astype(jnp.float32), k_mean)
        gate = jnp.where(blk_ids < qblk, gate, -jnp.inf)
        _, sel = lax.top_k(gate, k_sel)
        valid = sel < qblk
        ks = kb[bi, hi, sel]
        vs = vb[bi, hi, sel]
        s_sel = jnp.einsum('bhqd,bhqrkd->bhqrk', qc, ks).astype(jnp.float32)
        s_sel = jnp.where(valid[..., None], s_sel, -jnp.inf).reshape(
            b, MOBA_HEADS, Q_CHUNK, k_sel * MOBA_BLOCK)
        k_own = lax.dynamic_index_in_dim(kb, qblk, axis=2, keepdims=False)
        v_own = lax.dynamic_index_in_dim(vb, qblk, axis=2, keepdims=False)
        s_own = jnp.einsum('bhqd,bhkd->bhqk', qc, k_own).astype(jnp.float32)
        own_pos = qblk * MOBA_BLOCK + key_off
        s_own = jnp.where(own_pos[None, :] <= qpos[:, None], s_own, -jnp.inf)
        p = jax.nn.softmax(jnp.concatenate([s_sel, s_own], axis=-1), axis=-1).astype(v.dtype)
        p_sel = p[..., :k_sel * MOBA_BLOCK].reshape(b, MOBA_HEADS, Q_CHUNK, k_sel, MOBA_BLOCK)
        p_own = p[..., k_sel * MOBA_BLOCK:]
        return (jnp.einsum('bhqrk,bhqrkd->bhqd', p_sel, vs)
                + jnp.einsum('bhqk,bhkd->bhqd', p_own, v_own))

    o = lax.map(chunk, jnp.arange(s // Q_CHUNK))
    o = jnp.transpose(o, (1, 0, 3, 2, 4)).reshape(b, s, D_MODEL)
    return o @ w_o


def memory_cross_attention(h, mem_n, w_q, w_kv, w_o):
    b, s, _ = h.shape
    m = mem_n.shape[1]
    q = (h @ w_q).reshape(b, s, MEM_HEADS, MEM_HEAD_DIM)
    kv = (mem_n @ w_kv).reshape(b, m, 2, MEM_HEADS, MEM_HEAD_DIM)
    k, v = kv[:, :, 0], kv[:, :, 1]
    sc = jnp.einsum('bshd,bmhd->bhsm', q, k).astype(jnp.float32) * (MEM_HEAD_DIM ** -0.5)
    p = jax.nn.softmax(sc, axis=-1).astype(v.dtype)
    o = jnp.einsum('bhsm,bmhd->bshd', p, v).reshape(b, s, D_MODEL)
    return o @ w_o


def sq_relu_mlp(h, w1, w2):
    a = jax.nn.relu(h @ w1)
    return (a * a) @ w2


def setup_inputs(seed: int = 0) -> dict:
    key = jax.random.key(seed)
    ks = jax.random.split(key, 16)
    f32 = jnp.float32

    def w(k, shape, fan_in):
        return jax.random.normal(k, shape, f32) * (fan_in ** -0.5)

    return {
        "x": jax.random.normal(ks[0], (BATCH, SEQ, D_MODEL), f32),
        "mem": jax.random.normal(ks[1], (BATCH, N_MEM, D_MODEL), f32),
        "norm_gains": 1.0 + 0.02 * jax.random.normal(ks[2], (DEPTH, N_NORMS, D_MODEL), f32),
        "mem_norm": 1.0 + 0.02 * jax.random.normal(ks[3], (DEPTH, D_MODEL), f32),
        "pool_w_in": w(ks[4], (N_POOL_LAYERS, D_MODEL, D_MODEL), D_MODEL),
        "pool_w_group": w(ks[5], (N_POOL_LAYERS, POOL_GROUPS, POOL_GW, POOL_GW), POOL_GW),
        "pool_scale": 1.0 + 0.1 * jax.random.normal(ks[6], (N_POOL_LAYERS, D_MODEL), f32),
        "moba_w_qkv": w(ks[7], (N_MOBA_LAYERS, D_MODEL, 3 * D_MODEL), D_MODEL),
        "moba_w_o": w(ks[8], (N_MOBA_LAYERS, D_MODEL, D_MODEL), D_MODEL),
        "xa_w_q": w(ks[9], (DEPTH, D_MODEL, D_MODEL), D_MODEL),
        "xa_w_kv": w(ks[10], (DEPTH, D_MODEL, 2 * D_MODEL), D_MODEL),
        "xa_w_o": w(ks[11], (DEPTH, D_MODEL, D_MODEL), D_MODEL),
        "mlp_w1": w(ks[12], (DEPTH, D_MODEL, D_FF), D_MODEL),
        "mlp_w2": w(ks[13], (DEPTH, D_FF, D_MODEL), D_FF),
    }


def reference(x, mem, norm_gains, mem_norm, pool_w_in, pool_w_group, pool_scale,
              moba_w_qkv, moba_w_o, xa_w_q, xa_w_kv, xa_w_o, mlp_w1, mlp_w2):
    s = x.shape[1]
    pos = jnp.arange(s, dtype=jnp.float32)
    inv_freq = ROPE_THETA ** (-jnp.arange(0, ROT_DIM, 2, dtype=jnp.float32) / ROT_DIM)
    ang = pos[:, None] * inv_freq[None, :]
    cos, sin = jnp.cos(ang), jnp.sin(ang)
    for i in range(DEPTH):
        j = i // N_MIXERS
        hn = rms_norm(x, norm_gains[i, 0])
        if i % N_MIXERS == 0:
            y = pool_mixer(hn, pool_w_in[j], pool_w_group[j], pool_scale[j])
        else:
            y = moba_attention(hn, moba_w_qkv[j], moba_w_o[j], cos, sin)
        x = x + rms_norm(y, norm_gains[i, 1])
        mem_n = rms_norm(mem, mem_norm[i])
        y = memory_cross_attention(rms_norm(x, norm_gains[i, 2]), mem_n,
                                   xa_w_q[i], xa_w_kv[i], xa_w_o[i])
        x = x + rms_norm(y, norm_gains[i, 3])
        y = sq_relu_mlp(rms_norm(x, norm_gains[i, 4]), mlp_w1[i], mlp_w2[i])
        x = x + rms_norm(y, norm_gains[i, 5])
    return x
```

```cpp
#include <hip/hip_runtime.h>
#include <hip/hip_cooperative_groups.h>
#include <cstdio>
#include <cstdint>
namespace cg = cooperative_groups;

#ifndef MULTI_LAUNCH
#define MULTI_LAUNCH 0
#endif

#define LAS __attribute__((address_space(3)))
typedef _Float16 f16;
typedef _Float16 h8 __attribute__((ext_vector_type(8)));
typedef _Float16 h4 __attribute__((ext_vector_type(4)));
typedef _Float16 h2 __attribute__((ext_vector_type(2)));
typedef short s16x4 __attribute__((ext_vector_type(4)));
typedef float f32x2 __attribute__((ext_vector_type(2)));
typedef float f32x4 __attribute__((ext_vector_type(4)));
typedef float f32x16 __attribute__((ext_vector_type(16)));
typedef unsigned u32x4 __attribute__((ext_vector_type(4)));
typedef unsigned u32x2 __attribute__((ext_vector_type(2)));

constexpr int DM = 1024, BATCH = 8, SEQ = 2048, DEPTH = 4, NMEM = 256, DFF = 4096;
constexpr int M = BATCH * SEQ;
constexpr float RMS_EPS = 1e-6f;
constexpr float LOG2E = 1.4426950408889634f;

constexpr size_t MiB = 1u << 20;
constexpr size_t WS_KMEAN = 0;
constexpr size_t WS_ROPE = 512 * 1024;
constexpr size_t WS_W = 1 * MiB;
constexpr size_t WS_KVM = 60 * MiB;
constexpr size_t WS_R1 = 92 * MiB;
constexpr size_t WS_BIG = 124 * MiB;
constexpr size_t WS_END = 252 * MiB;
constexpr size_t WP_IN = 0, WP_GRP = 2 * MiB, WP_XQ = 3 * MiB, WP_XO = 5 * MiB, WP_W1 = 7 * MiB, WP_W2 = 15 * MiB;
constexpr size_t WM_QKV = 23 * MiB, WM_O = 29 * MiB, WM_XQ = 31 * MiB, WM_XO = 33 * MiB, WM_W1 = 35 * MiB, WM_W2 = 43 * MiB;

constexpr int LDS_BYTES = 131072;

__device__ __forceinline__ unsigned pk_f16(float lo, float hi) { f32x2 v = {lo, hi}; h2 h = __builtin_convertvector(v, h2); return __builtin_bit_cast(unsigned, h); }
__device__ __forceinline__ float wave_sum(float v) {
#pragma unroll
  for (int o = 1; o < 64; o <<= 1) v += __shfl_xor(v, o);
  return v;
}

constexpr int BM = 256, BK = 64, HALF = 128, HTB = HALF * BK * 2, NXCD = 8, WGM = 8;
__device__ __forceinline__ int lds_byte(int r, int c) { const int st = (r >> 4) * 2 + (c >> 5), rr = r & 15, cc = c & 31, ob = rr * 64 + cc * 2; return st * 1024 + (ob ^ (((ob >> 9) & 1) << 5)); }
__device__ __forceinline__ void stage_rc(int b, int& R, int& C) { const int st = b / 1024, sb = b % 1024, swz = sb ^ (((sb >> 9) & 1) << 5); R = (st >> 1) * 16 + swz / 64; C = (st & 1) * 32 + (swz % 64) / 2; }
__device__ __forceinline__ int perm32(int rho) { const int n = rho >> 4, i = rho & 15; return 8 * (i >> 2) + 4 * n + (i & 3); }

struct Unit { int pm, pn; };
enum { EPI_F16 = 0, EPI_QKV = 1 };
enum { GM_NORMAL = 0, GM_GROUPED = 1, GM_KVM = 2 };
struct GemmDesc {
  const f16* A; const f16* Bt; int lda, ldb, K, nM, nN, mode;
  int epi, act; f16* O; int ldc; const float* colscale; float cscale;
  const float* rope; float* kmean;
};

__device__ __forceinline__ bool sched_next(const GemmDesc& g, int G, int c, int i, Unit& u) {
  const int nM = g.nM, nN = g.nN, nwg = nM * nN;
  const long L = (long)i * G + c; if (L >= nwg) return false;
  int wgid = (int)L; { const int q = nwg / NXCD, r = nwg % NXCD, xcd = wgid % NXCD, off = wgid / NXCD; wgid = (xcd < r ? xcd * (q + 1) : r * (q + 1) + (xcd - r) * q) + off; }
  const int nig = WGM * nN, gid = wgid / nig, fm = gid * WGM, gsz = (nM - fm) < WGM ? (nM - fm) : WGM;
  u.pm = fm + ((wgid % nig) % gsz); u.pn = (wgid % nig) / gsz; return true;
}

__device__ __forceinline__ void gemm_epilogue(const f32x4 (&acc)[2][2][4][2], const GemmDesc& g, const Unit& u, int wr, int wc, int fr, int fq) {
  const int row0 = u.pm * BM + wr * 64 + fr;
  const int col0 = u.pn * BM + wc * 32 + 8 * fq;
  if (g.epi == EPI_F16) {
    float cs[2][8];
#pragma unroll
    for (int bj = 0; bj < 2; ++bj) {
      if (g.colscale) { const f32x4 a = *(const f32x4*)(g.colscale + col0 + bj * HALF), b = *(const f32x4*)(g.colscale + col0 + bj * HALF + 4);
        cs[bj][0] = a[0] * g.cscale; cs[bj][1] = a[1] * g.cscale; cs[bj][2] = a[2] * g.cscale; cs[bj][3] = a[3] * g.cscale;
        cs[bj][4] = b[0] * g.cscale; cs[bj][5] = b[1] * g.cscale; cs[bj][6] = b[2] * g.cscale; cs[bj][7] = b[3] * g.cscale;
      } else {
#pragma unroll
        for (int e = 0; e < 8; ++e) cs[bj][e] = g.cscale;
      }
    }
    const bool act = g.act != 0;
#pragma unroll
    for (int ai = 0; ai < 2; ++ai)
#pragma unroll
      for (int m = 0; m < 4; ++m) {
        f16* rowp = g.O + (size_t)(row0 + ai * HALF + m * 16) * g.ldc + col0;
#pragma unroll
        for (int bj = 0; bj < 2; ++bj) {
          f32x4 v0 = acc[ai][bj][m][0], v1 = acc[ai][bj][m][1];
          if (act) {
#pragma unroll
            for (int e = 0; e < 4; ++e) { float a = fmaxf(v0[e], 0.f); v0[e] = a * a; float b = fmaxf(v1[e], 0.f); v1[e] = b * b; }
          }
          u32x4 w;
          w.x = pk_f16(v0[0] * cs[bj][0], v0[1] * cs[bj][1]); w.y = pk_f16(v0[2] * cs[bj][2], v0[3] * cs[bj][3]);
          w.z = pk_f16(v1[0] * cs[bj][4], v1[1] * cs[bj][5]); w.w = pk_f16(v1[2] * cs[bj][6], v1[3] * cs[bj][7]);
          *(u32x4*)(rowp + bj * HALF) = w;
        }
      }
  } else {
    const int which = u.pn >> 2;
    const bool dorope = (which < 2) && (wc == 0);
    const float qs = (which == 0) ? g.cscale : 1.f;
    float ksum[2][8];
#pragma unroll
    for (int bj = 0; bj < 2; ++bj)
#pragma unroll
      for (int e = 0; e < 8; ++e) ksum[bj][e] = 0.f;
#pragma unroll
    for (int ai = 0; ai < 2; ++ai)
#pragma unroll
      for (int m = 0; m < 4; ++m) {
        const int row = row0 + ai * HALF + m * 16;
        f16* rowp = g.O + (size_t)row * g.ldc + col0;
        float cv[8], sv[8];
        if (dorope) {
          const float* rp = g.rope + (size_t)(row & (SEQ - 1)) * 16 + 8 * (fq & 1);
          const f32x4 c0 = *(const f32x4*)rp, c1 = *(const f32x4*)(rp + 4), s0 = *(const f32x4*)(rp + SEQ * 16), s1 = *(const f32x4*)(rp + SEQ * 16 + 4);
          const float sg = (fq < 2) ? -1.f : 1.f;
#pragma unroll
          for (int e = 0; e < 4; ++e) { cv[e] = c0[e]; cv[4 + e] = c1[e]; sv[e] = s0[e] * sg; sv[4 + e] = s1[e] * sg; }
        }
#pragma unroll
        for (int bj = 0; bj < 2; ++bj) {
          float v[8];
#pragma unroll
          for (int e = 0; e < 4; ++e) { v[e] = acc[ai][bj][m][0][e]; v[4 + e] = acc[ai][bj][m][1][e]; }
          if (dorope) {
#pragma unroll
            for (int e = 0; e < 8; ++e) { const float p = __shfl_xor(v[e], 32); v[e] = v[e] * cv[e] + p * sv[e]; }
          }
          if (which == 1) {
#pragma unroll
            for (int e = 0; e < 8; ++e) ksum[bj][e] += v[e];
          }
          u32x4 w;
          w.x = pk_f16(v[0] * qs, v[1] * qs); w.y = pk_f16(v[2] * qs, v[3] * qs); w.z = pk_f16(v[4] * qs, v[5] * qs); w.w = pk_f16(v[6] * qs, v[7] * qs);
          *(u32x4*)(rowp + bj * HALF) = w;
        }
      }
    if (which == 1) {
      const int b = u.pm >> 3, blk = u.pm & 7;
#pragma unroll
      for (int bj = 0; bj < 2; ++bj) {
        const int head = 2 * (u.pn & 3) + bj;
        float* kp = g.kmean + ((size_t)((b * 8 + head) * 8 + blk)) * 128 + wc * 32 + 8 * fq;
#pragma unroll
        for (int e = 0; e < 8; ++e) {
          float s = ksum[bj][e];
          s += __shfl_xor(s, 1); s += __shfl_xor(s, 2); s += __shfl_xor(s, 4); s += __shfl_xor(s, 8);
          if (fr == 0) atomicAdd(kp + e, s);
        }
      }
    }
  }
}

__device__ __forceinline__ void gemm_phase(LAS unsigned char* lds, const GemmDesc& g, int G, int c, const int tid) {
  const int wid = __builtin_amdgcn_readfirstlane(tid >> 6), lane = tid & 63, wr = wid >> 2, wc = wid & 3, fr = lane & 15, fq = lane >> 4;
  const int K = g.K, nt = K / BK;
  unsigned voffA[2], voffB[2];
#pragma unroll
  for (int i = 0; i < 2; ++i) { int R, C; stage_rc(tid * 16 + i * 8192, R, C); const int Rb = (R & ~31) + perm32(R & 31);
    voffA[i] = (unsigned)(R * g.lda + C) * 2u; voffB[i] = (unsigned)(Rb * g.ldb + C) * 2u; }
  const size_t kstep = (size_t)(BK * 2);
  const size_t hstepA = (size_t)HALF * g.lda * 2, hstepB = (size_t)HALF * g.ldb * 2;
  const size_t tstepA = 2 * hstepA, tstepB = 2 * hstepB;
  const unsigned ldsw = (unsigned)wid * 1024u;
  const int aoff = lds_byte(wr * 64 + fr, fq * 8), boff = lds_byte(wc * 32 + fr, fq * 8);
#define UA(u) ((size_t)(u).pm * tstepA + (g.mode == GM_GROUPED ? (size_t)(u).pn * 512 : 0))
#define UB(u) ((size_t)(g.mode == GM_KVM ? (((u).pm >> 3) * 8 + (u).pn) : (u).pn) * tstepB)
#define PG8_SA(b, h) (((b) * 2 + (h)) * HTB)
#define PG8_SB(b, h) ((4 + (b) * 2 + (h)) * HTB)
#define PG8_STAGE(bufoff, gbase, voff) do { _Pragma("unroll") for (int _i = 0; _i < 2; ++_i) \
    __builtin_amdgcn_global_load_lds((const unsigned*)((const char*)(gbase) + (voff)[_i]), (LAS unsigned*)(lds + (bufoff) + ldsw + _i * 8192), 16, 0, 0); } while (0)
#define PG8_LDA(dst, b, h) do { _Pragma("unroll") for (int m = 0; m < 4; ++m) _Pragma("unroll") for (int k = 0; k < 2; ++k) dst[m][k] = *(const LAS h8*)(lds + PG8_SA(b, h) + aoff + m * 2048 + k * 1024); } while (0)
#define PG8_LDB(dst, b, h) do { _Pragma("unroll") for (int n = 0; n < 2; ++n) _Pragma("unroll") for (int k = 0; k < 2; ++k) dst[n][k] = *(const LAS h8*)(lds + PG8_SB(b, h) + boff + n * 2048 + k * 1024); } while (0)
#define PG8_MMA(ai, bj, At, Bt) do { __builtin_amdgcn_s_setprio(1); _Pragma("unroll") for (int m = 0; m < 4; ++m) _Pragma("unroll") for (int n = 0; n < 2; ++n) _Pragma("unroll") for (int k = 0; k < 2; ++k) \
    acc[ai][bj][m][n] = __builtin_amdgcn_mfma_f32_16x16x32_f16(Bt[n][k], At[m][k], acc[ai][bj][m][n], 0, 0, 0); __builtin_amdgcn_s_setprio(0); } while (0)
#define PG8_WAIT_V(n) asm volatile("s_waitcnt vmcnt(" #n ")" ::: "memory")
#define PG8_WAIT_L(n) asm volatile("s_waitcnt lgkmcnt(" #n ")" ::: "memory")
#define PG8_BAR __builtin_amdgcn_s_barrier()
#define PG8_SCHED __builtin_amdgcn_sched_barrier(0)
  Unit cur, nxt; int ui = 0;
  if (!sched_next(g, G, c, 0, cur)) return;
  f32x4 acc[2][2][4][2];
#pragma unroll
  for (int a = 0; a < 2; ++a)
#pragma unroll
    for (int b = 0; b < 2; ++b)
#pragma unroll
      for (int m = 0; m < 4; ++m)
#pragma unroll
        for (int n = 0; n < 2; ++n) acc[a][b][m][n] = (f32x4){0.f, 0.f, 0.f, 0.f};
  h8 At[4][2], B0[2][2], B1[2][2];
  const char* cA = (const char*)g.A + UA(cur); const char* cB = (const char*)g.Bt + UB(cur);
  PG8_STAGE(PG8_SB(0, 0), cB, voffB); PG8_STAGE(PG8_SB(0, 1), cB + hstepB, voffB); PG8_STAGE(PG8_SA(0, 0), cA, voffA); PG8_STAGE(PG8_SA(0, 1), cA + hstepA, voffA);
  if (wr == 1) PG8_BAR;
  PG8_WAIT_V(2); PG8_BAR;
  PG8_STAGE(PG8_SB(1, 0), cB + kstep, voffB); PG8_STAGE(PG8_SA(1, 0), cA + kstep, voffA); PG8_STAGE(PG8_SB(1, 1), cB + hstepB + kstep, voffB);
  PG8_WAIT_V(6); PG8_BAR;
  for (;;) {
    const bool has_next = sched_next(g, G, c, ui + 1, nxt);
    const char* nA = has_next ? (const char*)g.A + UA(nxt) : cA; const char* nB = has_next ? (const char*)g.Bt + UB(nxt) : cB;
    for (int t = 0; t < nt; t += 2) {
      const bool last = (t == nt - 2);
      const char* a1 = cA + (size_t)(t + 1) * kstep;
      const char* a2 = last ? nA : cA + (size_t)(t + 2) * kstep; const char* b2 = last ? nB : cB + (size_t)(t + 2) * kstep;
      const char* a3 = a2 + kstep; const char* b3 = b2 + kstep;
      PG8_LDB(B0, 0, 0); PG8_LDB(B1, 0, 1); PG8_SCHED; PG8_LDA(At, 0, 0); PG8_STAGE(PG8_SA(1, 1), a1 + hstepA, voffA);
      PG8_WAIT_V(8); PG8_WAIT_L(0); PG8_BAR; PG8_MMA(0, 0, At, B0); PG8_MMA(0, 1, At, B1); PG8_BAR; PG8_SCHED;
      PG8_LDA(At, 0, 1); PG8_STAGE(PG8_SB(0, 0), b2, voffB); PG8_STAGE(PG8_SB(0, 1), b2 + hstepB, voffB); PG8_STAGE(PG8_SA(0, 0), a2, voffA);
      PG8_WAIT_V(8); PG8_WAIT_L(0); PG8_BAR; PG8_MMA(1, 0, At, B0); PG8_MMA(1, 1, At, B1); PG8_BAR; PG8_SCHED;
      PG8_LDB(B0, 1, 0); PG8_LDB(B1, 1, 1); PG8_SCHED; PG8_LDA(At, 1, 0); PG8_STAGE(PG8_SA(0, 1), a2 + hstepA, voffA);
      PG8_WAIT_V(8); PG8_WAIT_L(0); PG8_BAR; PG8_MMA(0, 0, At, B0); PG8_MMA(0, 1, At, B1); PG8_BAR; PG8_SCHED;
      PG8_LDA(At, 1, 1); PG8_STAGE(PG8_SB(1, 0), b3, voffB); PG8_STAGE(PG8_SB(1, 1), b3 + hstepB, voffB); PG8_STAGE(PG8_SA(1, 0), a3, voffA);
      PG8_WAIT_V(8); PG8_WAIT_L(0); PG8_BAR; PG8_MMA(1, 0, At, B0); PG8_MMA(1, 1, At, B1); PG8_BAR; PG8_SCHED;
    }
    if (wr == 0) PG8_BAR;
    gemm_epilogue(acc, g, cur, wr, wc, fr, fq);
    if (!has_next) break;
#pragma unroll
    for (int a = 0; a < 2; ++a)
#pragma unroll
      for (int b = 0; b < 2; ++b)
#pragma unroll
        for (int m = 0; m < 4; ++m)
#pragma unroll
          for (int n = 0; n < 2; ++n) acc[a][b][m][n] = (f32x4){0.f, 0.f, 0.f, 0.f};
    cur = nxt; cA = nA; cB = nB; ++ui;
    if (wr == 1) PG8_BAR;
  }
  PG8_WAIT_V(0);
  PG8_BAR;
#undef UA
#undef UB
#undef PG8_SA
#undef PG8_SB
#undef PG8_STAGE
#undef PG8_LDA
#undef PG8_LDB
#undef PG8_MMA
#undef PG8_WAIT_V
#undef PG8_WAIT_L
#undef PG8_BAR
#undef PG8_SCHED
}

__device__ __forceinline__ s16x4 vtr(const LAS unsigned char* p) { return __builtin_amdgcn_ds_read_tr16_b64_v4i16((LAS s16x4*)p); }

template <int HD, bool MOBA>
__device__ __forceinline__ void attn_unit(LAS unsigned char* lds, const f16* Qg, int ldq, const f16* Kg, const f16* Vg, int ldkv,
                                          f16* Og, int ldo, int qb, const float* kmg, const int tid) {
  constexpr int KS = HD * 2 + 16, VS = 320, KT_BYTES = 64 * KS, VT_BYTES = 64 * VS;
  constexpr int NSTEP = HD / 16, NPASS = HD / 128, KCH = HD / 8, KPT = 64 * KCH / 512, VPT = 2;
  LAS unsigned char* Kl = lds; LAS unsigned char* Vl = lds + KT_BYTES; LAS float* kml = (LAS float*)(lds + KT_BYTES + VT_BYTES);
  const int lane = tid & 63, wid = __builtin_amdgcn_readfirstlane(tid >> 6), r32 = lane & 31, hi = lane >> 5;
  const float NEG = -INFINITY;
  constexpr bool QREG = (HD == 128);
  constexpr int NQF = QREG ? NSTEP : 1;
  h8 qf[NQF];
  const f16* qrow = Qg + (size_t)(wid * 32 + r32) * ldq + hi * 8;
  if (QREG) {
#pragma unroll
    for (int s = 0; s < NQF; ++s) qf[s] = *(const h8*)(qrow + s * 16); }
  unsigned selmask = 0;
  if (MOBA) {
    for (int idx = tid; idx < qb * 128; idx += 512) kml[idx] = kmg[idx];
    __syncthreads();
    float gate[7];
#pragma unroll
    for (int j = 0; j < 7; ++j) {
      gate[j] = NEG;
      if (j < qb) {
        float a = 0.f;
#pragma unroll
        for (int s = 0; s < NSTEP; ++s) {
          const f32x4 k0 = *(const LAS f32x4*)(kml + j * 128 + s * 16 + hi * 8), k1 = *(const LAS f32x4*)(kml + j * 128 + s * 16 + hi * 8 + 4);
          a += (float)qf[s][0] * k0[0] + (float)qf[s][1] * k0[1] + (float)qf[s][2] * k0[2] + (float)qf[s][3] * k0[3]
             + (float)qf[s][4] * k1[0] + (float)qf[s][5] * k1[1] + (float)qf[s][6] * k1[2] + (float)qf[s][7] * k1[3];
        }
        a += __shfl_xor(a, 32);
        gate[j] = a;
      }
    }
    if (qb <= 3) selmask = (1u << qb) - 1u;
    else {
#pragma unroll
      for (int rnd = 0; rnd < 3; ++rnd) {
        float best = NEG; int bi = 0;
#pragma unroll
        for (int j = 0; j < 7; ++j) { const bool ok = (j < qb) && !((selmask >> j) & 1u) && (gate[j] > best); if (ok) { best = gate[j]; bi = j; } }
        selmask |= 1u << bi;
      }
    }
  }
  const int NT = MOBA ? 4 * (qb + 1) : 4;
  const LAS unsigned char* kb = Kl + r32 * KS + hi * 16;
  const LAS unsigned char* vb = Vl + (((lane & 15) >> 2) + 4 * hi) * VS + (16 * ((lane >> 4) & 1) + 4 * (lane & 3)) * 2;
#pragma unroll 1
  for (int pass = 0; pass < NPASS; ++pass) {
    f32x16 o[4];
#pragma unroll
    for (int d = 0; d < 4; ++d)
#pragma unroll
      for (int r = 0; r < 16; ++r) o[d][r] = 0.f;
    float m_run = NEG, l_run = 0.f;
    u32x4 kreg[KPT], vreg[VPT];
#define ATT_KEY0(t) (MOBA ? (((t) < 4 ? qb : (((t) - 4) >> 2)) * 256 + ((t) & 3) * 64) : (t) * 64)
#define ATT_LOAD(t) do { const int key0_ = ATT_KEY0(t); \
      _Pragma("unroll") for (int i = 0; i < KPT; ++i) { const int id = tid + 512 * i, row = id / KCH, ch = id % KCH; kreg[i] = *(const u32x4*)(Kg + (size_t)(key0_ + row) * ldkv + ch * 8); } \
      _Pragma("unroll") for (int i = 0; i < VPT; ++i) { const int id = tid + 512 * i, row = id >> 4, ch = id & 15; vreg[i] = *(const u32x4*)(Vg + pass * 128 + (size_t)(key0_ + row) * ldkv + ch * 8); } } while (0)
    ATT_LOAD(0);
#pragma unroll 1
    for (int t = 0; t < NT; ++t) {
#pragma unroll
      for (int i = 0; i < KPT; ++i) { const int id = tid + 512 * i, row = id / KCH, ch = id % KCH; *(LAS u32x4*)(Kl + row * KS + ch * 16) = kreg[i]; }
#pragma unroll
      for (int i = 0; i < VPT; ++i) { const int id = tid + 512 * i, row = id >> 4, ch = id & 15; *(LAS u32x4*)(Vl + row * VS + ch * 16) = vreg[i]; }
      __syncthreads();
      if (t + 1 < NT) ATT_LOAD(t + 1);
      const int blk = MOBA ? (t < 4 ? qb : ((t - 4) >> 2)) : 0, kt = t & 3;
      const bool own = MOBA && (t < 4);
      bool need = true;
      if (MOBA) { if (own) need = (kt <= (wid >> 1)); else need = (__ballot((selmask >> blk) & 1u) != 0ull); }
      if (need) {
        f32x16 p0, p1;
#pragma unroll
        for (int r = 0; r < 16; ++r) { p0[r] = 0.f; p1[r] = 0.f; }
        const f16* qr = qrow; if (!QREG) asm volatile("" : "+v"(qr));
#pragma unroll
        for (int s = 0; s < NSTEP; ++s) {
          const h8 k0 = *(const LAS h8*)(kb + s * 32), k1 = *(const LAS h8*)(kb + 32 * KS + s * 32);
          const h8 q = QREG ? qf[QREG ? s : 0] : *(const h8*)(qr + s * 16);
          p0 = __builtin_amdgcn_mfma_f32_32x32x16_f16(k0, q, p0, 0, 0, 0);
          p1 = __builtin_amdgcn_mfma_f32_32x32x16_f16(k1, q, p1, 0, 0, 0);
        }
        if (MOBA) {
          if (own) {
            const int qpos = wid * 32 + r32, kbase = kt * 64 + 4 * hi;
#pragma unroll
            for (int r = 0; r < 16; ++r) { const int kv = kbase + (r & 3) + 8 * (r >> 2); if (kv > qpos) p0[r] = NEG; if (kv + 32 > qpos) p1[r] = NEG; }
          } else if (!((selmask >> blk) & 1u)) {
#pragma unroll
            for (int r = 0; r < 16; ++r) { p0[r] = NEG; p1[r] = NEG; }
          }
        }
        float mx = fmaxf(p0[0], p1[0]);
#pragma unroll
        for (int r = 1; r < 16; ++r) mx = fmaxf(mx, fmaxf(p0[r], p1[r]));
        mx = fmaxf(mx, __shfl_xor(mx, 32));
        const float m_new = fmaxf(m_run, mx);
        const float alpha = __builtin_amdgcn_exp2f(m_run - m_new);
        m_run = m_new;
        float ps = 0.f;
#pragma unroll
        for (int r = 0; r < 16; ++r) { p0[r] = __builtin_amdgcn_exp2f(p0[r] - m_new); p1[r] = __builtin_amdgcn_exp2f(p1[r] - m_new); ps += p0[r] + p1[r]; }
        l_run = l_run * alpha + ps;
#pragma unroll
        for (int d = 0; d < 4; ++d)
#pragma unroll
          for (int r = 0; r < 16; ++r) o[d][r] *= alpha;
        h8 pf[4];
        { u32x4 w;
          w.x = pk_f16(p0[0], p0[1]); w.y = pk_f16(p0[2], p0[3]); w.z = pk_f16(p0[4], p0[5]); w.w = pk_f16(p0[6], p0[7]); pf[0] = __builtin_bit_cast(h8, w);
          w.x = pk_f16(p0[8], p0[9]); w.y = pk_f16(p0[10], p0[11]); w.z = pk_f16(p0[12], p0[13]); w.w = pk_f16(p0[14], p0[15]); pf[1] = __builtin_bit_cast(h8, w);
          w.x = pk_f16(p1[0], p1[1]); w.y = pk_f16(p1[2], p1[3]); w.z = pk_f16(p1[4], p1[5]); w.w = pk_f16(p1[6], p1[7]); pf[2] = __builtin_bit_cast(h8, w);
          w.x = pk_f16(p1[8], p1[9]); w.y = pk_f16(p1[10], p1[11]); w.z = pk_f16(p1[12], p1[13]); w.w = pk_f16(p1[14], p1[15]); pf[3] = __builtin_bit_cast(h8, w); }
#pragma unroll
        for (int d = 0; d < 4; ++d)
#pragma unroll
          for (int s = 0; s < 4; ++s) {
            const s16x4 lo = vtr(vb + (16 * s) * VS + d * 64), hh = vtr(vb + (16 * s + 8) * VS + d * 64);
            typedef short s16x8 __attribute__((ext_vector_type(8)));
            const s16x8 av = {lo[0], lo[1], lo[2], lo[3], hh[0], hh[1], hh[2], hh[3]};
            o[d] = __builtin_amdgcn_mfma_f32_32x32x16_f16(__builtin_bit_cast(h8, av), pf[s], o[d], 0, 0, 0);
          }
      }
      __syncthreads();
    }
#undef ATT_LOAD
#undef ATT_KEY0
    const float l = l_run + __shfl_xor(l_run, 32);
    const float inv = 1.0f / l;
    f16* orow = Og + (size_t)(wid * 32 + r32) * ldo + pass * 128 + 4 * hi;
#pragma unroll
    for (int d = 0; d < 4; ++d)
#pragma unroll
      for (int rg = 0; rg < 4; ++rg) {
        u32x2 w; w.x = pk_f16(o[d][4 * rg] * inv, o[d][4 * rg + 1] * inv); w.y = pk_f16(o[d][4 * rg + 2] * inv, o[d][4 * rg + 3] * inv);
        *(u32x2*)(orow + 32 * d + 8 * rg) = w;
      }
  }
}

__device__ __forceinline__ void ew_phase(int vcu, int G, int wave, int lane, const float* xin, float* X, f16* R1, const float* gpost, const float* gpre) {
  f32x4 gp[4], gq[4];
#pragma unroll
  for (int j = 0; j < 4; ++j) { gp[j] = gpost ? *(const f32x4*)(gpost + lane * 4 + 256 * j) : (f32x4){0.f, 0.f, 0.f, 0.f}; gq[j] = gpre ? *(const f32x4*)(gpre + lane * 4 + 256 * j) : (f32x4){0.f, 0.f, 0.f, 0.f}; }
  for (int m = vcu * 8 + wave; m < M; m += G * 8) {
    const float* xr = (xin ? xin : X) + (size_t)m * DM + lane * 4;
    f16* rr = R1 + (size_t)m * DM + lane * 4;
    f32x4 xv[4];
#pragma unroll
    for (int j = 0; j < 4; ++j) xv[j] = *(const f32x4*)(xr + 256 * j);
    if (gpost) {
      f32x4 yv[4]; float ss = 0.f;
#pragma unroll
      for (int j = 0; j < 4; ++j) { const h4 y = *(const h4*)(rr + 256 * j); yv[j] = (f32x4){(float)y[0], (float)y[1], (float)y[2], (float)y[3]}; ss += yv[j][0] * yv[j][0] + yv[j][1] * yv[j][1] + yv[j][2] * yv[j][2] + yv[j][3] * yv[j][3]; }
      const float rstd = 1.0f / sqrtf(wave_sum(ss) * (1.0f / DM) + RMS_EPS);
#pragma unroll
      for (int j = 0; j < 4; ++j) xv[j] = xv[j] + yv[j] * rstd * gp[j];
    }
    float* xo = X + (size_t)m * DM + lane * 4;
#pragma unroll
    for (int j = 0; j < 4; ++j) *(f32x4*)(xo + 256 * j) = xv[j];
    if (gpre) {
      float ss = 0.f;
#pragma unroll
      for (int j = 0; j < 4; ++j) ss += xv[j][0] * xv[j][0] + xv[j][1] * xv[j][1] + xv[j][2] * xv[j][2] + xv[j][3] * xv[j][3];
      const float rstd = 1.0f / sqrtf(wave_sum(ss) * (1.0f / DM) + RMS_EPS);
#pragma unroll
      for (int j = 0; j < 4; ++j) { const f32x4 h = xv[j] * rstd * gq[j]; u32x2 w; w.x = pk_f16(h[0], h[1]); w.y = pk_f16(h[2], h[3]); *(u32x2*)(rr + 256 * j) = w; }
    }
  }
}

__device__ __forceinline__ void pool_phase(int vcu, int G, const f16* U, f16* P, const int tid) {
  for (int id = vcu * 512 + tid; id < (M / 16) * 128; id += G * 512) {
    const int chunk = id & 127, run = id >> 7, grp = chunk >> 5, w = 2 << grp;
    const int row0 = run * 16, t0 = row0 & (SEQ - 1);
    const f16* up = U + (size_t)row0 * DM + chunk * 8;
    f16* pp = P + (size_t)row0 * DM + chunk * 8;
    float sum[8];
#pragma unroll
    for (int e = 0; e < 8; ++e) sum[e] = 0.f;
    for (int k = 1; k < w; ++k) {
      if (t0 - k >= 0) { const h8 v = *(const h8*)(up - (size_t)k * DM);
#pragma unroll
        for (int e = 0; e < 8; ++e) sum[e] += (float)v[e]; }
    }
    for (int i = 0; i < 16; ++i) {
      const int t = t0 + i;
      const h8 cur = *(const h8*)(up + (size_t)i * DM);
      const float rc = 1.0f / (float)(t + 1 < w ? t + 1 : w);
      float o[8];
#pragma unroll
      for (int e = 0; e < 8; ++e) { sum[e] += (float)cur[e]; o[e] = sum[e] * rc - (float)cur[e]; }
      u32x4 wv; wv.x = pk_f16(o[0], o[1]); wv.y = pk_f16(o[2], o[3]); wv.z = pk_f16(o[4], o[5]); wv.w = pk_f16(o[6], o[7]);
      *(u32x4*)(pp + (size_t)i * DM) = wv;
      if (t - w + 1 >= 0) { const h8 old = *(const h8*)(up + (size_t)(i - w + 1) * DM);
#pragma unroll
        for (int e = 0; e < 8; ++e) sum[e] -= (float)old[e]; }
    }
  }
}

__device__ __forceinline__ void conv_matrix(const float* W, int K, int N, f16* WT, int ldk, LAS float* scr, int gw, int NGW, int lane) {
  const int nblk = N / 32, nitems = (K / 64) * nblk;
  for (int item = gw; item < nitems; item += NGW) {
    const int kb = item / nblk, nb = item % nblk, k0 = 64 * kb, n0 = 32 * nb;
#pragma unroll 8
    for (int i = 0; i < 32; ++i) { const int kk = 2 * i + (lane >> 5); scr[kk * 33 + (lane & 31)] = W[(size_t)(k0 + kk) * N + n0 + (lane & 31)]; }
    asm volatile("s_waitcnt lgkmcnt(0)" ::: "memory");
    const int c = lane & 7;
#pragma unroll
    for (int j = 0; j < 4; ++j) { const int n = (lane >> 3) + 8 * j; const LAS float* s = scr + (8 * c) * 33 + n;
      u32x4 o; o.x = pk_f16(s[0 * 33], s[1 * 33]); o.y = pk_f16(s[2 * 33], s[3 * 33]); o.z = pk_f16(s[4 * 33], s[5 * 33]); o.w = pk_f16(s[6 * 33], s[7 * 33]);
      *(u32x4*)(WT + (size_t)(n0 + n) * ldk + k0 + 8 * c) = o; }
    asm volatile("s_waitcnt lgkmcnt(0)" ::: "memory");
  }
}

__device__ const double INV_FREQ[16] = {
  1.0, 0.44036660267178046, 0.19392274474868576, 0.08539710028576561, 0.03760603093086393, 0.016560440080994446,
  0.007292664737217109, 0.003211445994752591, 0.001414213562373095, 0.000622772421914596, 0.0002742481756762073,
  0.00012076973741146504, 5.318295896944988e-05, 2.341999896140934e-05, 1.031338537721246e-05, 4.5416704806078695e-06 };

struct Args { const float* in[14]; float* out; unsigned char* ws; int ph_lo, ph_hi; };

__device__ __forceinline__ void conv_layer(const Args& a, int i, LAS float* scr, int gw, int NGW, int lane) {
  unsigned char* wb = a.ws + WS_W; const int j = i >> 1;
  if ((i & 1) == 0) {
    conv_matrix(a.in[4] + (size_t)j * DM * DM, DM, DM, (f16*)(wb + WP_IN), DM, scr, gw, NGW, lane);
    for (int g = 0; g < 4; ++g) conv_matrix(a.in[5] + (size_t)(j * 4 + g) * 65536, 256, 256, (f16*)(wb + WP_GRP) + g * 65536, 256, scr, gw, NGW, lane);
    conv_matrix(a.in[9] + (size_t)i * DM * DM, DM, DM, (f16*)(wb + WP_XQ), DM, scr, gw, NGW, lane);
    conv_matrix(a.in[11] + (size_t)i * DM * DM, DM, DM, (f16*)(wb + WP_XO), DM, scr, gw, NGW, lane);
    conv_matrix(a.in[12] + (size_t)i * DM * DFF, DM, DFF, (f16*)(wb + WP_W1), DM, scr, gw, NGW, lane);
    conv_matrix(a.in[13] + (size_t)i * DFF * DM, DFF, DM, (f16*)(wb + WP_W2), DFF, scr, gw, NGW, lane);
  } else {
    conv_matrix(a.in[7] + (size_t)j * DM * 3 * DM, DM, 3 * DM, (f16*)(wb + WM_QKV), DM, scr, gw, NGW, lane);
    conv_matrix(a.in[8] + (size_t)j * DM * DM, DM, DM, (f16*)(wb + WM_O), DM, scr, gw, NGW, lane);
    conv_matrix(a.in[9] + (size_t)i * DM * DM, DM, DM, (f16*)(wb + WM_XQ), DM, scr, gw, NGW, lane);
    conv_matrix(a.in[11] + (size_t)i * DM * DM, DM, DM, (f16*)(wb + WM_XO), DM, scr, gw, NGW, lane);
    conv_matrix(a.in[12] + (size_t)i * DM * DFF, DM, DFF, (f16*)(wb + WM_W1), DM, scr, gw, NGW, lane);
    conv_matrix(a.in[13] + (size_t)i * DFF * DM, DFF, DM, (f16*)(wb + WM_W2), DFF, scr, gw, NGW, lane);
  }
}

constexpr int NPHASE = 2 + 11 * DEPTH;

__global__ void __launch_bounds__(512, 2) mega_fwd(Args a) {
  extern __shared__ __attribute__((aligned(16))) unsigned char lds_raw[];
  LAS unsigned char* lds = (LAS unsigned char*)lds_raw;
  const int G = gridDim.x, bx = blockIdx.x;
  const int vcu = (G % 8 == 0) ? (bx % 8) * (G / 8) + bx / 8 : bx;
  const int NGW = G * 8;
  unsigned char* ws = a.ws;
  float* X = a.out;
  f16* R1 = (f16*)(ws + WS_R1);
  f16* BIG = (f16*)(ws + WS_BIG);
  f16* KVM = (f16*)(ws + WS_KVM);
  float* KMEAN = (float*)(ws + WS_KMEAN);
  float* ROPE = (float*)(ws + WS_ROPE);
  const float* gains = a.in[2];

#pragma unroll 1
  for (int ph = a.ph_lo; ph < a.ph_hi; ++ph) {
    if (ph > a.ph_lo) cg::this_grid().sync();
    int tid = threadIdx.x; asm volatile("" : "+v"(tid));
    const int lane = tid & 63, wave = __builtin_amdgcn_readfirstlane(tid >> 6), gw = vcu * 8 + wave;
    LAS float* scr = (LAS float*)(lds + wave * 16384);
    enum { K_NONE, K_GEMM, K_EW, K_POOL, K_MOBA, K_XATT, K_PRO };
    int kind = K_NONE;
    GemmDesc g; g.A = nullptr; g.Bt = nullptr; g.lda = DM; g.ldb = DM; g.K = DM; g.nM = M / BM; g.nN = 4; g.mode = GM_NORMAL;
    g.epi = EPI_F16; g.act = 0; g.O = nullptr; g.ldc = DM; g.colscale = nullptr; g.cscale = 1.f; g.rope = ROPE; g.kmean = KMEAN;
    const float* ew_post = nullptr; const float* ew_pre = nullptr; int li = 0; bool conv23 = false;
    if (ph == 0) kind = K_PRO;
    else if (ph == 1) {
      kind = K_GEMM; g.A = BIG; g.Bt = BIG + 8 * MiB; g.nM = 32; g.nN = 8; g.mode = GM_KVM; g.O = KVM; g.ldc = 2048;
    } else {
      li = (ph - 2) / 11; const int s = (ph - 2) % 11; const bool moba = (li & 1) != 0;
      const f16* wl = (const f16*)(ws + WS_W);
      const float* gl = gains + (size_t)li * 6 * DM;
      switch (s) {
        case 0:
          kind = K_GEMM; g.A = R1;
          if (!moba) { g.Bt = wl + WP_IN / 2; g.O = BIG; }
          else { g.Bt = wl + WM_QKV / 2; g.nN = 12; g.O = BIG; g.ldc = 3 * DM; g.epi = EPI_QKV; g.cscale = 0.08838834764831845f * LOG2E; g.kmean = KMEAN + (size_t)(li >> 1) * 65536; }
          break;
        case 1: kind = moba ? K_MOBA : K_POOL; break;
        case 2:
          kind = K_GEMM; g.O = R1;
          if (!moba) { g.A = BIG + 16 * MiB; g.Bt = wl + WP_GRP / 2; g.ldb = 256; g.K = 256; g.mode = GM_GROUPED; g.colscale = a.in[6] + (size_t)(li >> 1) * DM; }
          else { g.A = BIG + 48 * MiB; g.Bt = wl + WM_O / 2; }
          break;
        case 3: kind = K_EW; ew_post = gl + 1 * DM; ew_pre = gl + 2 * DM; break;
        case 4: kind = K_GEMM; g.A = R1; g.Bt = wl + (moba ? WM_XQ : WP_XQ) / 2; g.O = BIG; g.cscale = 0.0625f * LOG2E; break;
        case 5: kind = K_XATT; break;
        case 6: kind = K_GEMM; g.A = BIG + 16 * MiB; g.Bt = wl + (moba ? WM_XO : WP_XO) / 2; g.O = R1; break;
        case 7: kind = K_EW; ew_post = gl + 3 * DM; ew_pre = gl + 4 * DM; break;
        case 8: kind = K_GEMM; g.A = R1; g.Bt = wl + (moba ? WM_W1 : WP_W1) / 2; g.nN = 16; g.O = BIG; g.ldc = DFF; g.act = 1; break;
        case 9: kind = K_GEMM; g.A = BIG; g.lda = DFF; g.Bt = wl + (moba ? WM_W2 : WP_W2) / 2; g.ldb = DFF; g.K = DFF; g.O = R1; break;
        default: kind = K_EW; ew_post = gl + 5 * DM; ew_pre = (li + 1 < DEPTH) ? gl + 6 * DM : nullptr; conv23 = (li == 1); break;
      }
    }

    if (kind == K_GEMM) {
      gemm_phase(lds, g, G, bx, tid);
    } else if (kind == K_EW) {
      ew_phase(vcu, G, wave, lane, nullptr, X, R1, ew_post, ew_pre);
      if (conv23) { conv_layer(a, 2, scr, gw, NGW, lane); conv_layer(a, 3, scr, gw, NGW, lane); }
    } else if (kind == K_POOL) {
      pool_phase(vcu, G, BIG, BIG + 16 * MiB, tid);
    } else if (kind == K_MOBA) {
      const float* km = KMEAN + (size_t)(li >> 1) * 65536;
      for (int uid = vcu; uid < 512; uid += G) {
        const int bh = (uid & 255) >> 2, qb = (uid < 256) ? (uid & 3) : 7 - (uid & 3), b = bh >> 3, h = bh & 7;
        const f16* base = BIG + (size_t)b * SEQ * 3 * DM + h * 128;
        attn_unit<128, true>(lds, base + (size_t)qb * 256 * 3 * DM, 3 * DM, base + DM, base + 2 * DM, 3 * DM,
                             BIG + 48 * MiB + (size_t)(b * SEQ + qb * 256) * DM + h * 128, DM, qb, km + (size_t)bh * 8 * 128, tid);
      }
    } else if (kind == K_XATT) {
      for (int uid = vcu; uid < 256; uid += G) {
        const int b = uid >> 5, h = (uid >> 3) & 3, qt = uid & 7;
        const f16* kv = KVM + (size_t)li * 2048 * 2048 + (size_t)b * NMEM * 2048 + h * 256;
        attn_unit<256, false>(lds, BIG + (size_t)(b * SEQ + qt * 256) * DM + h * 256, DM, kv, kv + DM, 2048,
                              BIG + 16 * MiB + (size_t)(b * SEQ + qt * 256) * DM + h * 256, DM, 0, nullptr, tid);
      }
    } else if (kind == K_PRO) {
      conv_layer(a, 0, scr, gw, NGW, lane); conv_layer(a, 1, scr, gw, NGW, lane);
      for (int i = 0; i < DEPTH; ++i) conv_matrix(a.in[10] + (size_t)i * DM * 2 * DM, DM, 2 * DM, BIG + 8 * MiB + (size_t)i * 2048 * DM, DM, scr, gw, NGW, lane);
      for (int r = gw; r < BATCH * NMEM; r += NGW) {
        const float* mr = a.in[1] + (size_t)r * DM + lane * 4; f32x4 v[4]; float ss = 0.f;
#pragma unroll
        for (int j = 0; j < 4; ++j) { v[j] = *(const f32x4*)(mr + 256 * j); ss += v[j][0] * v[j][0] + v[j][1] * v[j][1] + v[j][2] * v[j][2] + v[j][3] * v[j][3]; }
        const float rstd = 1.0f / sqrtf(wave_sum(ss) * (1.0f / DM) + RMS_EPS);
        for (int i = 0; i < DEPTH; ++i) {
          const float* gm = a.in[3] + (size_t)i * DM + lane * 4; f16* orow = BIG + ((size_t)i * 2048 + r) * DM + lane * 4;
#pragma unroll
          for (int j = 0; j < 4; ++j) { const f32x4 gg = *(const f32x4*)(gm + 256 * j); const f32x4 h = v[j] * rstd * gg; u32x2 w; w.x = pk_f16(h[0], h[1]); w.y = pk_f16(h[2], h[3]); *(u32x2*)(orow + 256 * j) = w; }
        }
      }
      for (int id = vcu * 512 + tid; id < SEQ * 16; id += G * 512) {
        const int pos = id >> 4, i = id & 15;
        const double rev = (double)pos * INV_FREQ[i] * 0.15915494309189535;
        const float fr = (float)(rev - (double)(long long)rev);
        ROPE[id] = __builtin_amdgcn_cosf(fr); ROPE[SEQ * 16 + id] = __builtin_amdgcn_sinf(fr);
      }
      for (int id = vcu * 512 + tid; id < 2 * 65536; id += G * 512) KMEAN[id] = 0.f;
      ew_phase(vcu, G, wave, lane, a.in[0], X, R1, nullptr, gains);
    }
    __syncthreads();
  }
}

extern "C" void kernel_launch(void* const* d_in, const int* in_sizes, int n_in, void* d_out, int out_size, void* d_ws, size_t ws_size, hipStream_t stream) {
  static int grid = 0;
  if (grid == 0) {
    int dev = 0, cus = 0, per_cu = 0;
    hipGetDevice(&dev);
    hipDeviceGetAttribute(&cus, hipDeviceAttributeMultiprocessorCount, dev);
    hipFuncSetAttribute((const void*)mega_fwd, hipFuncAttributeMaxDynamicSharedMemorySize, LDS_BYTES);
    hipOccupancyMaxActiveBlocksPerMultiprocessor(&per_cu, (const void*)mega_fwd, 512, LDS_BYTES);
    if (per_cu < 1) { fprintf(stderr, "occupancy query returned %d\n", per_cu); per_cu = 1; }
    (void)hipGetLastError();
    grid = cus;
    if (ws_size < WS_END) fprintf(stderr, "workspace too small: %zu\n", ws_size);
  }
  Args a{};
  for (int i = 0; i < 14; ++i) a.in[i] = (const float*)d_in[i];
  a.out = (float*)d_out; a.ws = (unsigned char*)d_ws;
#if MULTI_LAUNCH
  for (int ph = 0; ph < NPHASE; ++ph) { a.ph_lo = ph; a.ph_hi = ph + 1; hipLaunchKernelGGL(mega_fwd, dim3(grid), dim3(512), LDS_BYTES, stream, a); }
#else
  a.ph_lo = 0; a.ph_hi = NPHASE;
  void* args[] = {&a};
  hipError_t e = hipLaunchCooperativeKernel((const void*)mega_fwd, dim3(grid), dim3(512), args, LDS_BYTES, stream);
  if (e != hipSuccess) fprintf(stderr, "cooperative launch failed: %s (grid %d)\n", hipGetErrorString(e), grid);
#endif
}
```

```cpp
#include <hip/hip_runtime.h>
#include <hip/hip_cooperative_groups.h>
#include <cstdio>
#include <cstdint>
namespace cg = cooperative_groups;

#ifndef PROBE
#define PROBE 0
#endif
#ifndef MULTI_LAUNCH
#define MULTI_LAUNCH 0
#endif

#define LAS __attribute__((address_space(3)))
typedef _Float16 f16;
typedef _Float16 h8 __attribute__((ext_vector_type(8)));
typedef _Float16 h4 __attribute__((ext_vector_type(4)));
typedef _Float16 h2 __attribute__((ext_vector_type(2)));
typedef short s16x4 __attribute__((ext_vector_type(4)));
typedef float f32x2 __attribute__((ext_vector_type(2)));
typedef float f32x4 __attribute__((ext_vector_type(4)));
typedef float f32x16 __attribute__((ext_vector_type(16)));
typedef unsigned u32x4 __attribute__((ext_vector_type(4)));
typedef unsigned u32x2 __attribute__((ext_vector_type(2)));

constexpr int DM = 1024, BATCH = 8, SEQ = 2048, DEPTH = 4, NMEM = 256, DFF = 4096;
constexpr int M = BATCH * SEQ;
constexpr float RMS_EPS = 1e-6f;
constexpr float LOG2E = 1.4426950408889634f;

constexpr size_t MiB = 1u << 20;
constexpr size_t WS_KMEAN = 0;
constexpr size_t WS_ROPE = 512 * 1024;
constexpr size_t WS_W = 1 * MiB;
constexpr size_t WS_KVM = 60 * MiB;
constexpr size_t WS_R1 = 92 * MiB;
constexpr size_t WS_BIG = 124 * MiB;
constexpr size_t WS_END = 252 * MiB;
constexpr size_t WP_IN = 0, WP_GRP = 2 * MiB, WP_XQ = 3 * MiB, WP_XO = 5 * MiB, WP_W1 = 7 * MiB, WP_W2 = 15 * MiB;
constexpr size_t WM_QKV = 23 * MiB, WM_O = 29 * MiB, WM_XQ = 31 * MiB, WM_XO = 33 * MiB, WM_W1 = 35 * MiB, WM_W2 = 43 * MiB;

constexpr int LDS_BYTES = 131072 + 64;
constexpr size_t WS_BAR = 800 * 1024;

__device__ __forceinline__ unsigned pk_f16(float lo, float hi) { f32x2 v = {lo, hi}; h2 h = __builtin_convertvector(v, h2); return __builtin_bit_cast(unsigned, h); }
__device__ __forceinline__ float wave_sum(float v) {
#pragma unroll
  for (int o = 1; o < 64; o <<= 1) v += __shfl_xor(v, o);
  return v;
}

constexpr int BM = 256, BK = 64, HALF = 128, HTB = HALF * BK * 2, NXCD = 8, WGM = 8;
__device__ __forceinline__ int lds_byte(int r, int c) { const int st = (r >> 4) * 2 + (c >> 5), rr = r & 15, cc = c & 31, ob = rr * 64 + cc * 2; return st * 1024 + (ob ^ (((ob >> 9) & 1) << 5)); }
__device__ __forceinline__ void stage_rc(int b, int& R, int& C) { const int st = b / 1024, sb = b % 1024, swz = sb ^ (((sb >> 9) & 1) << 5); R = (st >> 1) * 16 + swz / 64; C = (st & 1) * 32 + (swz % 64) / 2; }
__device__ __forceinline__ int perm32(int rho) { const int n = rho >> 4, i = rho & 15; return 8 * (i >> 2) + 4 * n + (i & 3); }

struct Unit { int pm, pn; };
enum { EPI_F16 = 0, EPI_QKV = 1 };
enum { GM_NORMAL = 0, GM_GROUPED = 1, GM_KVM = 2 };
struct GemmDesc {
  const f16* A; const f16* Bt; int lda, ldb, K, nM, nN, mode;
  int epi, act; f16* O; int ldc; const float* colscale; float cscale;
  const float* rope; float* kmean;
};

__device__ __forceinline__ bool sched_next(const GemmDesc& g, int G, int c, int i, Unit& u) {
  const int nM = g.nM, nN = g.nN, nwg = nM * nN;
  const long L = (long)i * G + c; if (L >= nwg) return false;
  int wgid = (int)L; { const int q = nwg / NXCD, r = nwg % NXCD, xcd = wgid % NXCD, off = wgid / NXCD; wgid = (xcd < r ? xcd * (q + 1) : r * (q + 1) + (xcd - r) * q) + off; }
  const int nig = WGM * nN, gid = wgid / nig, fm = gid * WGM, gsz = (nM - fm) < WGM ? (nM - fm) : WGM;
  u.pm = fm + ((wgid % nig) % gsz); u.pn = (wgid % nig) / gsz; return true;
}

__device__ __forceinline__ void gemm_epilogue(const f32x4 (&acc)[2][2][4][2], const GemmDesc& g, const Unit& u, int wr, int wc, int fr, int fq) {
  const int row0 = u.pm * BM + wr * 64 + fr;
  const int col0 = u.pn * BM + wc * 32 + 8 * fq;
  if (g.epi == EPI_F16) {
    float cs[2][8];
#pragma unroll
    for (int bj = 0; bj < 2; ++bj) {
      if (g.colscale) { const f32x4 a = *(const f32x4*)(g.colscale + col0 + bj * HALF), b = *(const f32x4*)(g.colscale + col0 + bj * HALF + 4);
        cs[bj][0] = a[0] * g.cscale; cs[bj][1] = a[1] * g.cscale; cs[bj][2] = a[2] * g.cscale; cs[bj][3] = a[3] * g.cscale;
        cs[bj][4] = b[0] * g.cscale; cs[bj][5] = b[1] * g.cscale; cs[bj][6] = b[2] * g.cscale; cs[bj][7] = b[3] * g.cscale;
      } else {
#pragma unroll
        for (int e = 0; e < 8; ++e) cs[bj][e] = g.cscale;
      }
    }
    const bool act = g.act != 0;
#pragma unroll
    for (int ai = 0; ai < 2; ++ai)
#pragma unroll
      for (int m = 0; m < 4; ++m) {
        f16* rowp = g.O + (size_t)(row0 + ai * HALF + m * 16) * g.ldc + col0;
#pragma unroll
        for (int bj = 0; bj < 2; ++bj) {
          f32x4 v0 = acc[ai][bj][m][0], v1 = acc[ai][bj][m][1];
          if (act) {
#pragma unroll
            for (int e = 0; e < 4; ++e) { float a = fmaxf(v0[e], 0.f); v0[e] = a * a; float b = fmaxf(v1[e], 0.f); v1[e] = b * b; }
          }
          u32x4 w;
          w.x = pk_f16(v0[0] * cs[bj][0], v0[1] * cs[bj][1]); w.y = pk_f16(v0[2] * cs[bj][2], v0[3] * cs[bj][3]);
          w.z = pk_f16(v1[0] * cs[bj][4], v1[1] * cs[bj][5]); w.w = pk_f16(v1[2] * cs[bj][6], v1[3] * cs[bj][7]);
          *(u32x4*)(rowp + bj * HALF) = w;
        }
      }
  } else {
    const int which = u.pn >> 2;
    const bool dorope = (which < 2) && (wc == 0);
    const float qs = (which == 0) ? g.cscale : 1.f;
    float ksum[2][8];
#pragma unroll
    for (int bj = 0; bj < 2; ++bj)
#pragma unroll
      for (int e = 0; e < 8; ++e) ksum[bj][e] = 0.f;
#pragma unroll
    for (int ai = 0; ai < 2; ++ai)
#pragma unroll
      for (int m = 0; m < 4; ++m) {
        const int row = row0 + ai * HALF + m * 16;
        f16* rowp = g.O + (size_t)row * g.ldc + col0;
        float cv[8], sv[8];
        if (dorope) {
          const float* rp = g.rope + (size_t)(row & (SEQ - 1)) * 16 + 8 * (fq & 1);
          const f32x4 c0 = *(const f32x4*)rp, c1 = *(const f32x4*)(rp + 4), s0 = *(const f32x4*)(rp + SEQ * 16), s1 = *(const f32x4*)(rp + SEQ * 16 + 4);
          const float sg = (fq < 2) ? -1.f : 1.f;
#pragma unroll
          for (int e = 0; e < 4; ++e) { cv[e] = c0[e]; cv[4 + e] = c1[e]; sv[e] = s0[e] * sg; sv[4 + e] = s1[e] * sg; }
        }
#pragma unroll
        for (int bj = 0; bj < 2; ++bj) {
          float v[8];
#pragma unroll
          for (int e = 0; e < 4; ++e) { v[e] = acc[ai][bj][m][0][e]; v[4 + e] = acc[ai][bj][m][1][e]; }
          if (dorope) {
#pragma unroll
            for (int e = 0; e < 8; ++e) { const float p = __shfl_xor(v[e], 32); v[e] = v[e] * cv[e] + p * sv[e]; }
          }
          if (which == 1) {
#pragma unroll
            for (int e = 0; e < 8; ++e) ksum[bj][e] += v[e];
          }
          u32x4 w;
          w.x = pk_f16(v[0] * qs, v[1] * qs); w.y = pk_f16(v[2] * qs, v[3] * qs); w.z = pk_f16(v[4] * qs, v[5] * qs); w.w = pk_f16(v[6] * qs, v[7] * qs);
          *(u32x4*)(rowp + bj * HALF) = w;
        }
      }
    if (which == 1 && g.kmean) {
      const int b = u.pm >> 3, blk = u.pm & 7;
#pragma unroll
      for (int bj = 0; bj < 2; ++bj) {
        const int head = 2 * (u.pn & 3) + bj;
        float* kp = g.kmean + ((size_t)((b * 8 + head) * 8 + blk)) * 128 + wc * 32 + 8 * fq;
#pragma unroll
        for (int e = 0; e < 8; ++e) {
          float s = ksum[bj][e];
          s += __shfl_xor(s, 1); s += __shfl_xor(s, 2); s += __shfl_xor(s, 4); s += __shfl_xor(s, 8);
          if (fr == 0) atomicAdd(kp + e, s);
        }
      }
    }
  }
}

__device__ __forceinline__ void gemm_phase(LAS unsigned char* lds, const GemmDesc& g, int G, int c, const int tid) {
  const int wid = __builtin_amdgcn_readfirstlane(tid >> 6), lane = tid & 63, wr = wid >> 2, wc = wid & 3, fr = lane & 15, fq = lane >> 4;
  const int K = g.K, nt = K / BK;
  unsigned voffA[2], voffB[2];
#pragma unroll
  for (int i = 0; i < 2; ++i) { int R, C; stage_rc(tid * 16 + i * 8192, R, C); const int Rb = (R & ~31) + perm32(R & 31);
    voffA[i] = (unsigned)(R * g.lda + C) * 2u; voffB[i] = (unsigned)(Rb * g.ldb + C) * 2u; }
  const size_t kstep = (size_t)(BK * 2);
  const size_t hstepA = (size_t)HALF * g.lda * 2, hstepB = (size_t)HALF * g.ldb * 2;
  const size_t tstepA = 2 * hstepA, tstepB = 2 * hstepB;
  const unsigned ldsw = (unsigned)wid * 1024u;
  const int aoff = lds_byte(wr * 64 + fr, fq * 8), boff = lds_byte(wc * 32 + fr, fq * 8);
#define UA(u) ((size_t)(u).pm * tstepA + (g.mode == GM_GROUPED ? (size_t)(u).pn * 512 : 0))
#define UB(u) ((size_t)(g.mode == GM_KVM ? (((u).pm >> 3) * 8 + (u).pn) : (u).pn) * tstepB)
#define PG8_SA(b, h) (((b) * 2 + (h)) * HTB)
#define PG8_SB(b, h) ((4 + (b) * 2 + (h)) * HTB)
#define PG8_STAGE(bufoff, gbase, voff) do { _Pragma("unroll") for (int _i = 0; _i < 2; ++_i) \
    __builtin_amdgcn_global_load_lds((const unsigned*)((const char*)(gbase) + (voff)[_i]), (LAS unsigned*)(lds + (bufoff) + ldsw + _i * 8192), 16, 0, 0); } while (0)
#define PG8_LDA(dst, b, h) do { _Pragma("unroll") for (int m = 0; m < 4; ++m) _Pragma("unroll") for (int k = 0; k < 2; ++k) dst[m][k] = *(const LAS h8*)(lds + PG8_SA(b, h) + aoff + m * 2048 + k * 1024); } while (0)
#define PG8_LDB(dst, b, h) do { _Pragma("unroll") for (int n = 0; n < 2; ++n) _Pragma("unroll") for (int k = 0; k < 2; ++k) dst[n][k] = *(const LAS h8*)(lds + PG8_SB(b, h) + boff + n * 2048 + k * 1024); } while (0)
#define PG8_MMA(ai, bj, At, Bt) do { __builtin_amdgcn_s_setprio(1); _Pragma("unroll") for (int m = 0; m < 4; ++m) _Pragma("unroll") for (int n = 0; n < 2; ++n) _Pragma("unroll") for (int k = 0; k < 2; ++k) \
    acc[ai][bj][m][n] = __builtin_amdgcn_mfma_f32_16x16x32_f16(Bt[n][k], At[m][k], acc[ai][bj][m][n], 0, 0, 0); __builtin_amdgcn_s_setprio(0); } while (0)
#define PG8_WAIT_V(n) asm volatile("s_waitcnt vmcnt(" #n ")" ::: "memory")
#define PG8_WAIT_L(n) asm volatile("s_waitcnt lgkmcnt(" #n ")" ::: "memory")
#define PG8_BAR __builtin_amdgcn_s_barrier()
#define PG8_SCHED __builtin_amdgcn_sched_barrier(0)
  Unit cur, nxt; int ui = 0;
  if (!sched_next(g, G, c, 0, cur)) return;
  f32x4 acc[2][2][4][2];
#pragma unroll
  for (int a = 0; a < 2; ++a)
#pragma unroll
    for (int b = 0; b < 2; ++b)
#pragma unroll
      for (int m = 0; m < 4; ++m)
#pragma unroll
        for (int n = 0; n < 2; ++n) acc[a][b][m][n] = (f32x4){0.f, 0.f, 0.f, 0.f};
  h8 At[4][2], B0[2][2], B1[2][2];
  const char* cA = (const char*)g.A + UA(cur); const char* cB = (const char*)g.Bt + UB(cur);
  PG8_STAGE(PG8_SB(0, 0), cB, voffB); PG8_STAGE(PG8_SB(0, 1), cB + hstepB, voffB); PG8_STAGE(PG8_SA(0, 0), cA, voffA); PG8_STAGE(PG8_SA(0, 1), cA + hstepA, voffA);
  if (wr == 1) PG8_BAR;
  PG8_WAIT_V(2); PG8_BAR;
  PG8_STAGE(PG8_SB(1, 0), cB + kstep, voffB); PG8_STAGE(PG8_SA(1, 0), cA + kstep, voffA); PG8_STAGE(PG8_SB(1, 1), cB + hstepB + kstep, voffB);
  PG8_WAIT_V(6); PG8_BAR;
  for (;;) {
    const bool has_next = sched_next(g, G, c, ui + 1, nxt);
    const char* nA = has_next ? (const char*)g.A + UA(nxt) : cA; const char* nB = has_next ? (const char*)g.Bt + UB(nxt) : cB;
    for (int t = 0; t < nt; t += 2) {
      const bool last = (t == nt - 2);
      const char* a1 = cA + (size_t)(t + 1) * kstep;
      const char* a2 = last ? nA : cA + (size_t)(t + 2) * kstep; const char* b2 = last ? nB : cB + (size_t)(t + 2) * kstep;
      const char* a3 = a2 + kstep; const char* b3 = b2 + kstep;
      PG8_LDB(B0, 0, 0); PG8_LDB(B1, 0, 1); PG8_SCHED; PG8_LDA(At, 0, 0); PG8_STAGE(PG8_SA(1, 1), a1 + hstepA, voffA);
      PG8_WAIT_V(8); PG8_WAIT_L(0); PG8_BAR; PG8_MMA(0, 0, At, B0); PG8_MMA(0, 1, At, B1); PG8_BAR; PG8_SCHED;
      PG8_LDA(At, 0, 1); PG8_STAGE(PG8_SB(0, 0), b2, voffB); PG8_STAGE(PG8_SB(0, 1), b2 + hstepB, voffB); PG8_STAGE(PG8_SA(0, 0), a2, voffA);
      PG8_WAIT_V(8); PG8_WAIT_L(0); PG8_BAR; PG8_MMA(1, 0, At, B0); PG8_MMA(1, 1, At, B1); PG8_BAR; PG8_SCHED;
      PG8_LDB(B0, 1, 0); PG8_LDB(B1, 1, 1); PG8_SCHED; PG8_LDA(At, 1, 0); PG8_STAGE(PG8_SA(0, 1), a2 + hstepA, voffA);
      PG8_WAIT_V(8); PG8_WAIT_L(0); PG8_BAR; PG8_MMA(0, 0, At, B0); PG8_MMA(0, 1, At, B1); PG8_BAR; PG8_SCHED;
      PG8_LDA(At, 1, 1); PG8_STAGE(PG8_SB(1, 0), b3, voffB); PG8_STAGE(PG8_SB(1, 1), b3 + hstepB, voffB); PG8_STAGE(PG8_SA(1, 0), a3, voffA);
      PG8_WAIT_V(8); PG8_WAIT_L(0); PG8_BAR; PG8_MMA(1, 0, At, B0); PG8_MMA(1, 1, At, B1); PG8_BAR; PG8_SCHED;
    }
    if (wr == 0) PG8_BAR;
    gemm_epilogue(acc, g, cur, wr, wc, fr, fq);
    if (!has_next) break;
#pragma unroll
    for (int a = 0; a < 2; ++a)
#pragma unroll
      for (int b = 0; b < 2; ++b)
#pragma unroll
        for (int m = 0; m < 4; ++m)
#pragma unroll
          for (int n = 0; n < 2; ++n) acc[a][b][m][n] = (f32x4){0.f, 0.f, 0.f, 0.f};
    cur = nxt; cA = nA; cB = nB; ++ui;
    if (wr == 1) PG8_BAR;
  }
  PG8_WAIT_V(0);
  PG8_BAR;
#undef UA
#undef UB
#undef PG8_SA
#undef PG8_SB
#undef PG8_STAGE
#undef PG8_LDA
#undef PG8_LDB
#undef PG8_MMA
#undef PG8_WAIT_V
#undef PG8_WAIT_L
#undef PG8_BAR
#undef PG8_SCHED
}

__device__ __forceinline__ s16x4 vtr(const LAS unsigned char* p) { return __builtin_amdgcn_ds_read_tr16_b64_v4i16((LAS s16x4*)p); }

template <int HD, bool MOBA>
__device__ __forceinline__ void attn_unit(LAS unsigned char* lds, const f16* Qg, int ldq, const f16* Kg, const f16* Vg, int ldkv,
                                          f16* Og, int ldo, int qb, const float* kmg, const int tid) {
  constexpr int KS = HD * 2 + 16, VS = 320, KT_BYTES = 64 * KS, VT_BYTES = 64 * VS;
  constexpr int NSTEP = HD / 16, NPASS = HD / 128, KCH = HD / 8, KPT = 64 * KCH / 512, VPT = 2;
  LAS unsigned char* Kl = lds; LAS unsigned char* Vl = lds + KT_BYTES; LAS float* kml = (LAS float*)(lds + KT_BYTES + VT_BYTES);
  const int lane = tid & 63, wid = __builtin_amdgcn_readfirstlane(tid >> 6), r32 = lane & 31, hi = lane >> 5;
  const float NEG = -INFINITY;
  constexpr bool QREG = (HD == 128);
  constexpr int NQF = QREG ? NSTEP : 1;
  h8 qf[NQF];
  const f16* qrow = Qg + (size_t)(wid * 32 + r32) * ldq + hi * 8;
  if (QREG) {
#pragma unroll
    for (int s = 0; s < NQF; ++s) qf[s] = *(const h8*)(qrow + s * 16); }
  unsigned selmask = 0;
  if (MOBA) {
    for (int idx = tid; idx < qb * 128; idx += 512) kml[idx] = kmg[idx];
    __syncthreads();
    float gate[7];
#pragma unroll
    for (int j = 0; j < 7; ++j) {
      gate[j] = NEG;
      if (j < qb) {
        float a = 0.f;
#pragma unroll
        for (int s = 0; s < NSTEP; ++s) {
          const f32x4 k0 = *(const LAS f32x4*)(kml + j * 128 + s * 16 + hi * 8), k1 = *(const LAS f32x4*)(kml + j * 128 + s * 16 + hi * 8 + 4);
          a += (float)qf[s][0] * k0[0] + (float)qf[s][1] * k0[1] + (float)qf[s][2] * k0[2] + (float)qf[s][3] * k0[3]
             + (float)qf[s][4] * k1[0] + (float)qf[s][5] * k1[1] + (float)qf[s][6] * k1[2] + (float)qf[s][7] * k1[3];
        }
        a += __shfl_xor(a, 32);
        gate[j] = a;
      }
    }
    if (qb <= 3) selmask = (1u << qb) - 1u;
    else {
#pragma unroll
      for (int rnd = 0; rnd < 3; ++rnd) {
        float best = NEG; int bi = 0;
#pragma unroll
        for (int j = 0; j < 7; ++j) { const bool ok = (j < qb) && !((selmask >> j) & 1u) && (gate[j] > best); if (ok) { best = gate[j]; bi = j; } }
        selmask |= 1u << bi;
      }
    }
  }
  const int NT = MOBA ? 4 * (qb + 1) : 4;
  const LAS unsigned char* kb = Kl + r32 * KS + hi * 16;
  const LAS unsigned char* vb = Vl + (((lane & 15) >> 2) + 4 * hi) * VS + (16 * ((lane >> 4) & 1) + 4 * (lane & 3)) * 2;
#pragma unroll 1
  for (int pass = 0; pass < NPASS; ++pass) {
    f32x16 o[4];
#pragma unroll
    for (int d = 0; d < 4; ++d)
#pragma unroll
      for (int r = 0; r < 16; ++r) o[d][r] = 0.f;
    float m_run = NEG, l_run = 0.f;
    u32x4 kreg[KPT], vreg[VPT];
#define ATT_KEY0(t) (MOBA ? (((t) < 4 ? qb : (((t) - 4) >> 2)) * 256 + ((t) & 3) * 64) : (t) * 64)
#define ATT_LOAD(t) do { const int key0_ = ATT_KEY0(t); \
      _Pragma("unroll") for (int i = 0; i < KPT; ++i) { const int id = tid + 512 * i, row = id / KCH, ch = id % KCH; kreg[i] = *(const u32x4*)(Kg + (size_t)(key0_ + row) * ldkv + ch * 8); } \
      _Pragma("unroll") for (int i = 0; i < VPT; ++i) { const int id = tid + 512 * i, row = id >> 4, ch = id & 15; vreg[i] = *(const u32x4*)(Vg + pass * 128 + (size_t)(key0_ + row) * ldkv + ch * 8); } } while (0)
    ATT_LOAD(0);
#pragma unroll 1
    for (int t = 0; t < NT; ++t) {
#pragma unroll
      for (int i = 0; i < KPT; ++i) { const int id = tid + 512 * i, row = id / KCH, ch = id % KCH; *(LAS u32x4*)(Kl + row * KS + ch * 16) = kreg[i]; }
#pragma unroll
      for (int i = 0; i < VPT; ++i) { const int id = tid + 512 * i, row = id >> 4, ch = id & 15; *(LAS u32x4*)(Vl + row * VS + ch * 16) = vreg[i]; }
      __syncthreads();
      if (t + 1 < NT) ATT_LOAD(t + 1);
      const int blk = MOBA ? (t < 4 ? qb : ((t - 4) >> 2)) : 0, kt = t & 3;
      const bool own = MOBA && (t < 4);
      bool need = true;
      if (MOBA) { if (own) need = (kt <= (wid >> 1)); else need = (__ballot((selmask >> blk) & 1u) != 0ull); }
      if (need) {
        f32x16 p0, p1;
#pragma unroll
        for (int r = 0; r < 16; ++r) { p0[r] = 0.f; p1[r] = 0.f; }
        const f16* qr = qrow; if (!QREG) asm volatile("" : "+v"(qr));
#pragma unroll
        for (int s = 0; s < NSTEP; ++s) {
          const h8 k0 = *(const LAS h8*)(kb + s * 32), k1 = *(const LAS h8*)(kb + 32 * KS + s * 32);
          const h8 q = QREG ? qf[QREG ? s : 0] : *(const h8*)(qr + s * 16);
          p0 = __builtin_amdgcn_mfma_f32_32x32x16_f16(k0, q, p0, 0, 0, 0);
          p1 = __builtin_amdgcn_mfma_f32_32x32x16_f16(k1, q, p1, 0, 0, 0);
        }
        if (MOBA) {
          if (own) {
            const int qpos = wid * 32 + r32, kbase = kt * 64 + 4 * hi;
#pragma unroll
            for (int r = 0; r < 16; ++r) { const int kv = kbase + (r & 3) + 8 * (r >> 2); if (kv > qpos) p0[r] = NEG; if (kv + 32 > qpos) p1[r] = NEG; }
          } else if (!((selmask >> blk) & 1u)) {
#pragma unroll
            for (int r = 0; r < 16; ++r) { p0[r] = NEG; p1[r] = NEG; }
          }
        }
        float mx = fmaxf(p0[0], p1[0]);
#pragma unroll
        for (int r = 1; r < 16; ++r) mx = fmaxf(mx, fmaxf(p0[r], p1[r]));
        mx = fmaxf(mx, __shfl_xor(mx, 32));
        const float m_new = fmaxf(m_run, mx);
        const float alpha = __builtin_amdgcn_exp2f(m_run - m_new);
        m_run = m_new;
        float ps = 0.f;
#pragma unroll
        for (int r = 0; r < 16; ++r) { p0[r] = __builtin_amdgcn_exp2f(p0[r] - m_new); p1[r] = __builtin_amdgcn_exp2f(p1[r] - m_new); ps += p0[r] + p1[r]; }
        l_run = l_run * alpha + ps;
#pragma unroll
        for (int d = 0; d < 4; ++d)
#pragma unroll
          for (int r = 0; r < 16; ++r) o[d][r] *= alpha;
        h8 pf[4];
        { u32x4 w;
          w.x = pk_f16(p0[0], p0[1]); w.y = pk_f16(p0[2], p0[3]); w.z = pk_f16(p0[4], p0[5]); w.w = pk_f16(p0[6], p0[7]); pf[0] = __builtin_bit_cast(h8, w);
          w.x = pk_f16(p0[8], p0[9]); w.y = pk_f16(p0[10], p0[11]); w.z = pk_f16(p0[12], p0[13]); w.w = pk_f16(p0[14], p0[15]); pf[1] = __builtin_bit_cast(h8, w);
          w.x = pk_f16(p1[0], p1[1]); w.y = pk_f16(p1[2], p1[3]); w.z = pk_f16(p1[4], p1[5]); w.w = pk_f16(p1[6], p1[7]); pf[2] = __builtin_bit_cast(h8, w);
          w.x = pk_f16(p1[8], p1[9]); w.y = pk_f16(p1[10], p1[11]); w.z = pk_f16(p1[12], p1[13]); w.w = pk_f16(p1[14], p1[15]); pf[3] = __builtin_bit_cast(h8, w); }
#pragma unroll
        for (int d = 0; d < 4; ++d)
#pragma unroll
          for (int s = 0; s < 4; ++s) {
            const s16x4 lo = vtr(vb + (16 * s) * VS + d * 64), hh = vtr(vb + (16 * s + 8) * VS + d * 64);
            typedef short s16x8 __attribute__((ext_vector_type(8)));
            const s16x8 av = {lo[0], lo[1], lo[2], lo[3], hh[0], hh[1], hh[2], hh[3]};
            o[d] = __builtin_amdgcn_mfma_f32_32x32x16_f16(__builtin_bit_cast(h8, av), pf[s], o[d], 0, 0, 0);
          }
      }
      __syncthreads();
    }
#undef ATT_LOAD
#undef ATT_KEY0
    const float l = l_run + __shfl_xor(l_run, 32);
    const float inv = 1.0f / l;
    f16* orow = Og + (size_t)(wid * 32 + r32) * ldo + pass * 128 + 4 * hi;
#pragma unroll
    for (int d = 0; d < 4; ++d)
#pragma unroll
      for (int rg = 0; rg < 4; ++rg) {
        u32x2 w; w.x = pk_f16(o[d][4 * rg] * inv, o[d][4 * rg + 1] * inv); w.y = pk_f16(o[d][4 * rg + 2] * inv, o[d][4 * rg + 3] * inv);
        *(u32x2*)(orow + 32 * d + 8 * rg) = w;
      }
  }
}


#define XB_TMO      128
#define XB_XCNT(j)  (256  + 64 * (j))
#define XB_XSUB(j)  (1280 + 64 * (j))
#define XB_XGEN(j)  (2304 + 64 * (j))
#define XB_TOP      3328
#define XB_TOPGEN   3392
#define XCD_BAR_WORDS 3456
#define XB_SPIN_CAP (1u << 22)
__device__ __forceinline__ unsigned xb_ld(unsigned* p)              { return __hip_atomic_load(p, __ATOMIC_RELAXED, __HIP_MEMORY_SCOPE_AGENT); }
__device__ __forceinline__ unsigned xb_add(unsigned* p, unsigned v) { return __hip_atomic_fetch_add(p, v, __ATOMIC_RELAXED, __HIP_MEMORY_SCOPE_AGENT); }
__device__ __forceinline__ unsigned xb_xcc_id() { return (unsigned)__builtin_amdgcn_s_getreg((3 << 11) | 20) & 0xFu; }
#define XB_SPIN(cond, bar) do { unsigned _sp = 0; while (cond) { __builtin_amdgcn_s_sleep(1); \
    if ((++_sp & 255u) == 0u) { if (xb_ld(&(bar)[XB_TMO])) break; if (_sp > XB_SPIN_CAP) { atomicAdd(&(bar)[XB_TMO], 1u); break; } } } } while (0)
struct XcdBarrier { unsigned* bar; unsigned x; volatile LAS unsigned* st; };
__device__ __forceinline__ XcdBarrier xcd_barrier_post(unsigned* bar, volatile LAS unsigned* st) {
  XcdBarrier b; b.bar = bar; b.x = xb_xcc_id(); b.st = st;
  if (threadIdx.x == 0) (void)xb_add(&bar[XB_XCNT(b.x)], 1u);
  return b;
}
__device__ __forceinline__ void xcd_barrier_complete(unsigned* bar, unsigned x, unsigned& nloc, unsigned& nx) {
  const unsigned G = gridDim.x * gridDim.y * gridDim.z;
  unsigned sum, cnt, mine, sp = 0u;
  for (;;) {
    sum = 0u; cnt = 0u; mine = 0u;
#pragma unroll
    for (unsigned j = 0; j < 16; ++j) { const unsigned c = xb_ld(&bar[XB_XCNT(j)]); sum += c; cnt += (c > 0u) ? 1u : 0u; mine = (j == x) ? c : mine; }
    if (sum == G) break;
    __builtin_amdgcn_s_sleep(1);
    if ((++sp & 255u) == 0u) { if (xb_ld(&bar[XB_TMO])) break; if (sp > XB_SPIN_CAP) { atomicAdd(&bar[XB_TMO], 1u); break; } }
  }
  nloc = mine > 0u ? mine : 1u; nx = cnt > 0u ? cnt : 1u;
}
__device__ __forceinline__ void xcd_barrier(const XcdBarrier& b) {
  asm volatile("s_waitcnt vmcnt(0)" ::: "memory");
  __syncthreads();
  if (threadIdx.x == 0) {
    unsigned* bar = b.bar;
    __builtin_amdgcn_s_waitcnt(0);
    unsigned nloc = b.st[0], nx = b.st[1];
    if (nloc == 0u) { xcd_barrier_complete(bar, b.x, nloc, nx); b.st[0] = nloc; b.st[1] = nx; }
    const unsigned old = xb_add(&bar[XB_XSUB(b.x)], 1u);
    const unsigned gen = old / nloc;
    if (old + 1u == (gen + 1u) * nloc) {
      __builtin_amdgcn_fence(__ATOMIC_RELEASE, "agent");
      asm volatile("s_waitcnt vmcnt(0)" ::: "memory");
      const unsigned og = xb_add(&bar[XB_TOP], 1u);
      const unsigned tg = og / nx;
      if (og + 1u == (tg + 1u) * nx) xb_add(&bar[XB_TOPGEN], 1u);
      else XB_SPIN(xb_ld(&bar[XB_TOPGEN]) == tg, bar);
      __builtin_amdgcn_fence(__ATOMIC_ACQUIRE, "agent");
      xb_add(&bar[XB_XGEN(b.x)], 1u);
      asm volatile("s_waitcnt vmcnt(0)" ::: "memory");
    } else {
      XB_SPIN(xb_ld(&bar[XB_XGEN(b.x)]) == gen, bar);
      __builtin_amdgcn_fence(__ATOMIC_ACQUIRE, "agent");
      asm volatile("s_waitcnt vmcnt(0)" ::: "memory");
    }
  }
  __syncthreads();
}

__device__ __forceinline__ void ew_phase(int vcu, int G, int wave, int lane, const float* xin, float* X, f16* R1, const float* gpost, const float* gpre) {
  f32x4 gp[4], gq[4];
#pragma unroll
  for (int j = 0; j < 4; ++j) { gp[j] = gpost ? *(const f32x4*)(gpost + lane * 4 + 256 * j) : (f32x4){0.f, 0.f, 0.f, 0.f}; gq[j] = gpre ? *(const f32x4*)(gpre + lane * 4 + 256 * j) : (f32x4){0.f, 0.f, 0.f, 0.f}; }
  for (int m = vcu * 8 + wave; m < M; m += G * 8) {
    const float* xr = (xin ? xin : X) + (size_t)m * DM + lane * 4;
    f16* rr = R1 + (size_t)m * DM + lane * 4;
    f32x4 xv[4];
#pragma unroll
    for (int j = 0; j < 4; ++j) xv[j] = *(const f32x4*)(xr + 256 * j);
    if (gpost) {
      f32x4 yv[4]; float ss = 0.f;
#pragma unroll
      for (int j = 0; j < 4; ++j) { const h4 y = *(const h4*)(rr + 256 * j); yv[j] = (f32x4){(float)y[0], (float)y[1], (float)y[2], (float)y[3]}; ss += yv[j][0] * yv[j][0] + yv[j][1] * yv[j][1] + yv[j][2] * yv[j][2] + yv[j][3] * yv[j][3]; }
      const float rstd = 1.0f / sqrtf(wave_sum(ss) * (1.0f / DM) + RMS_EPS);
#pragma unroll
      for (int j = 0; j < 4; ++j) xv[j] = xv[j] + yv[j] * rstd * gp[j];
    }
    float* xo = X + (size_t)m * DM + lane * 4;
#pragma unroll
    for (int j = 0; j < 4; ++j) *(f32x4*)(xo + 256 * j) = xv[j];
    if (gpre) {
      float ss = 0.f;
#pragma unroll
      for (int j = 0; j < 4; ++j) ss += xv[j][0] * xv[j][0] + xv[j][1] * xv[j][1] + xv[j][2] * xv[j][2] + xv[j][3] * xv[j][3];
      const float rstd = 1.0f / sqrtf(wave_sum(ss) * (1.0f / DM) + RMS_EPS);
#pragma unroll
      for (int j = 0; j < 4; ++j) { const f32x4 h = xv[j] * rstd * gq[j]; u32x2 w; w.x = pk_f16(h[0], h[1]); w.y = pk_f16(h[2], h[3]); *(u32x2*)(rr + 256 * j) = w; }
    }
  }
}

__device__ __forceinline__ void pool_phase(int vcu, int G, const f16* U, f16* P, const int tid) {
  for (int id = vcu * 512 + tid; id < (M / 16) * 128; id += G * 512) {
    const int chunk = id & 127, run = id >> 7, grp = chunk >> 5, w = 2 << grp;
    const int row0 = run * 16, t0 = row0 & (SEQ - 1);
    const f16* up = U + (size_t)row0 * DM + chunk * 8;
    f16* pp = P + (size_t)row0 * DM + chunk * 8;
    float sum[8];
#pragma unroll
    for (int e = 0; e < 8; ++e) sum[e] = 0.f;
    for (int k = 1; k < w; ++k) {
      if (t0 - k >= 0) { const h8 v = *(const h8*)(up - (size_t)k * DM);
#pragma unroll
        for (int e = 0; e < 8; ++e) sum[e] += (float)v[e]; }
    }
    for (int i = 0; i < 16; ++i) {
      const int t = t0 + i;
      const h8 cur = *(const h8*)(up + (size_t)i * DM);
      const float rc = 1.0f / (float)(t + 1 < w ? t + 1 : w);
      float o[8];
#pragma unroll
      for (int e = 0; e < 8; ++e) { sum[e] += (float)cur[e]; o[e] = sum[e] * rc - (float)cur[e]; }
      u32x4 wv; wv.x = pk_f16(o[0], o[1]); wv.y = pk_f16(o[2], o[3]); wv.z = pk_f16(o[4], o[5]); wv.w = pk_f16(o[6], o[7]);
      *(u32x4*)(pp + (size_t)i * DM) = wv;
      if (t - w + 1 >= 0) { const h8 old = *(const h8*)(up + (size_t)(i - w + 1) * DM);
#pragma unroll
        for (int e = 0; e < 8; ++e) sum[e] -= (float)old[e]; }
    }
  }
}

__device__ __forceinline__ void conv_matrix(const float* W, int K, int N, f16* WT, int ldk, LAS float* scr, int gw, int NGW, int lane) {
  const int nblk = N / 32, nitems = (K / 64) * nblk;
  for (int item = gw; item < nitems; item += NGW) {
    const int kb = item / nblk, nb = item % nblk, k0 = 64 * kb, n0 = 32 * nb;
#pragma unroll 8
    for (int i = 0; i < 32; ++i) { const int kk = 2 * i + (lane >> 5); scr[kk * 33 + (lane & 31)] = W[(size_t)(k0 + kk) * N + n0 + (lane & 31)]; }
    asm volatile("s_waitcnt lgkmcnt(0)" ::: "memory");
    const int c = lane & 7;
#pragma unroll
    for (int j = 0; j < 4; ++j) { const int n = (lane >> 3) + 8 * j; const LAS float* s = scr + (8 * c) * 33 + n;
      u32x4 o; o.x = pk_f16(s[0 * 33], s[1 * 33]); o.y = pk_f16(s[2 * 33], s[3 * 33]); o.z = pk_f16(s[4 * 33], s[5 * 33]); o.w = pk_f16(s[6 * 33], s[7 * 33]);
      *(u32x4*)(WT + (size_t)(n0 + n) * ldk + k0 + 8 * c) = o; }
    asm volatile("s_waitcnt lgkmcnt(0)" ::: "memory");
  }
}

__device__ const double INV_FREQ[16] = {
  1.0, 0.44036660267178046, 0.19392274474868576, 0.08539710028576561, 0.03760603093086393, 0.016560440080994446,
  0.007292664737217109, 0.003211445994752591, 0.001414213562373095, 0.000622772421914596, 0.0002742481756762073,
  0.00012076973741146504, 5.318295896944988e-05, 2.341999896140934e-05, 1.031338537721246e-05, 4.5416704806078695e-06 };

struct Args { const float* in[14]; float* out; unsigned char* ws; int ph_lo, ph_hi; };

__device__ __forceinline__ void conv_layer(const Args& a, int i, LAS float* scr, int gw, int NGW, int lane) {
  unsigned char* wb = a.ws + WS_W; const int j = i >> 1;
  if ((i & 1) == 0) {
    conv_matrix(a.in[4] + (size_t)j * DM * DM, DM, DM, (f16*)(wb + WP_IN), DM, scr, gw, NGW, lane);
    for (int g = 0; g < 4; ++g) conv_matrix(a.in[5] + (size_t)(j * 4 + g) * 65536, 256, 256, (f16*)(wb + WP_GRP) + g * 65536, 256, scr, gw, NGW, lane);
    conv_matrix(a.in[9] + (size_t)i * DM * DM, DM, DM, (f16*)(wb + WP_XQ), DM, scr, gw, NGW, lane);
    conv_matrix(a.in[11] + (size_t)i * DM * DM, DM, DM, (f16*)(wb + WP_XO), DM, scr, gw, NGW, lane);
    conv_matrix(a.in[12] + (size_t)i * DM * DFF, DM, DFF, (f16*)(wb + WP_W1), DM, scr, gw, NGW, lane);
    conv_matrix(a.in[13] + (size_t)i * DFF * DM, DFF, DM, (f16*)(wb + WP_W2), DFF, scr, gw, NGW, lane);
  } else {
    conv_matrix(a.in[7] + (size_t)j * DM * 3 * DM, DM, 3 * DM, (f16*)(wb + WM_QKV), DM, scr, gw, NGW, lane);
    conv_matrix(a.in[8] + (size_t)j * DM * DM, DM, DM, (f16*)(wb + WM_O), DM, scr, gw, NGW, lane);
    conv_matrix(a.in[9] + (size_t)i * DM * DM, DM, DM, (f16*)(wb + WM_XQ), DM, scr, gw, NGW, lane);
    conv_matrix(a.in[11] + (size_t)i * DM * DM, DM, DM, (f16*)(wb + WM_XO), DM, scr, gw, NGW, lane);
    conv_matrix(a.in[12] + (size_t)i * DM * DFF, DM, DFF, (f16*)(wb + WM_W1), DM, scr, gw, NGW, lane);
    conv_matrix(a.in[13] + (size_t)i * DFF * DM, DFF, DM, (f16*)(wb + WM_W2), DFF, scr, gw, NGW, lane);
  }
}

constexpr int NPHASE = 2 + 11 * DEPTH;

__global__ void __launch_bounds__(512, 2) mega_fwd(Args a) {
  extern __shared__ __attribute__((aligned(16))) unsigned char lds_raw[];
  LAS unsigned char* lds = (LAS unsigned char*)lds_raw;
  const int G = gridDim.x, bx = blockIdx.x;
  const int vcu = (G % 8 == 0) ? (bx % 8) * (G / 8) + bx / 8 : bx;
  const int NGW = G * 8;
  unsigned char* ws = a.ws;
  float* X = a.out;
  f16* R1 = (f16*)(ws + WS_R1);
  f16* BIG = (f16*)(ws + WS_BIG);
  f16* KVM = (f16*)(ws + WS_KVM);
  float* KMEAN = (float*)(ws + WS_KMEAN);
  float* ROPE = (float*)(ws + WS_ROPE);
  const float* gains = a.in[2];

  volatile LAS unsigned* MISC = (volatile LAS unsigned*)(lds + 131072);
  if (threadIdx.x < 16) MISC[threadIdx.x] = 0u;
  __syncthreads();
  const XcdBarrier xbar = xcd_barrier_post((unsigned*)(ws + WS_BAR), MISC + 8);
#pragma unroll 1
  for (int ph = a.ph_lo; ph < a.ph_hi; ++ph) {
    if (ph > a.ph_lo) {
      if (ph == a.ph_lo + 1) cg::this_grid().sync();
      else xcd_barrier(xbar);
    }
    int tid = threadIdx.x; asm volatile("" : "+v"(tid));
    const int lane = tid & 63, wave = __builtin_amdgcn_readfirstlane(tid >> 6), gw = vcu * 8 + wave;
    LAS float* scr = (LAS float*)(lds + wave * 16384);
    enum { K_NONE, K_GEMM, K_EW, K_POOL, K_MOBA, K_XATT, K_PRO };
    int kind = K_NONE;
    GemmDesc g; g.A = nullptr; g.Bt = nullptr; g.lda = DM; g.ldb = DM; g.K = DM; g.nM = M / BM; g.nN = 4; g.mode = GM_NORMAL;
    g.epi = EPI_F16; g.act = 0; g.O = nullptr; g.ldc = DM; g.colscale = nullptr; g.cscale = 1.f; g.rope = ROPE; g.kmean = KMEAN;
    const float* ew_post = nullptr; const float* ew_pre = nullptr; int li = 0; bool conv23 = false;
    if (ph == 0) kind = K_PRO;
    else if (ph == 1) {
      kind = K_GEMM; g.A = BIG; g.Bt = BIG + 8 * MiB; g.nM = 32; g.nN = 8; g.mode = GM_KVM; g.O = KVM; g.ldc = 2048;
    } else {
      li = (ph - 2) / 11; const int s = (ph - 2) % 11; const bool moba = (li & 1) != 0;
      const f16* wl = (const f16*)(ws + WS_W);
      const float* gl = gains + (size_t)li * 6 * DM;
      switch (s) {
        case 0:
          kind = K_GEMM; g.A = R1;
          if (!moba) { g.Bt = wl + WP_IN / 2; g.O = BIG; }
          else { g.Bt = wl + WM_QKV / 2; g.nN = 12; g.O = BIG; g.ldc = 3 * DM; g.epi = EPI_QKV; g.cscale = 0.08838834764831845f * LOG2E; g.kmean = KMEAN + (size_t)(li >> 1) * 65536; }
          break;
        case 1: kind = moba ? K_MOBA : K_POOL; break;
        case 2:
          kind = K_GEMM; g.O = R1;
          if (!moba) { g.A = BIG + 16 * MiB; g.Bt = wl + WP_GRP / 2; g.ldb = 256; g.K = 256; g.mode = GM_GROUPED; g.colscale = a.in[6] + (size_t)(li >> 1) * DM; }
          else { g.A = BIG + 48 * MiB; g.Bt = wl + WM_O / 2; }
          break;
        case 3: kind = K_EW; ew_post = gl + 1 * DM; ew_pre = gl + 2 * DM; break;
        case 4: kind = K_GEMM; g.A = R1; g.Bt = wl + (moba ? WM_XQ : WP_XQ) / 2; g.O = BIG; g.cscale = 0.0625f * LOG2E; break;
        case 5: kind = K_XATT; break;
        case 6: kind = K_GEMM; g.A = BIG + 16 * MiB; g.Bt = wl + (moba ? WM_XO : WP_XO) / 2; g.O = R1; break;
        case 7: kind = K_EW; ew_post = gl + 3 * DM; ew_pre = gl + 4 * DM; break;
        case 8: kind = K_GEMM; g.A = R1; g.Bt = wl + (moba ? WM_W1 : WP_W1) / 2; g.nN = 16; g.O = BIG; g.ldc = DFF; g.act = 1; break;
        case 9: kind = K_GEMM; g.A = BIG; g.lda = DFF; g.Bt = wl + (moba ? WM_W2 : WP_W2) / 2; g.ldb = DFF; g.K = DFF; g.O = R1; break;
        default: kind = K_EW; ew_post = gl + 5 * DM; ew_pre = (li + 1 < DEPTH) ? gl + 6 * DM : nullptr; conv23 = (li == 1); break;
      }
    }

    if (kind == K_GEMM) {
#if PROBE == 1
#pragma unroll 1
      for (int rep = 0; rep < 2; ++rep) { gemm_phase(lds, g, G, bx, tid); __syncthreads(); g.kmean = nullptr; }
#else
      gemm_phase(lds, g, G, bx, tid);
#endif
    } else if (kind == K_EW) {
      ew_phase(vcu, G, wave, lane, nullptr, X, R1, ew_post, ew_pre);
      if (conv23) { conv_layer(a, 2, scr, gw, NGW, lane); conv_layer(a, 3, scr, gw, NGW, lane); }
    } else if (kind == K_POOL) {
      pool_phase(vcu, G, BIG, BIG + 16 * MiB, tid);
    } else if (kind == K_MOBA) {
      const float* km = KMEAN + (size_t)(li >> 1) * 65536;
#if PROBE == 2
      for (int rep = 0; rep < 2; ++rep)
#endif
      for (int uid = vcu; uid < 512; uid += G) {
        const int bh = (uid & 255) >> 2, qb = (uid < 256) ? (uid & 3) : 7 - (uid & 3), b = bh >> 3, h = bh & 7;
        const f16* base = BIG + (size_t)b * SEQ * 3 * DM + h * 128;
        attn_unit<128, true>(lds, base + (size_t)qb * 256 * 3 * DM, 3 * DM, base + DM, base + 2 * DM, 3 * DM,
                             BIG + 48 * MiB + (size_t)(b * SEQ + qb * 256) * DM + h * 128, DM, qb, km + (size_t)bh * 8 * 128, tid);
      }
    } else if (kind == K_XATT) {
#if PROBE == 2
      for (int rep = 0; rep < 2; ++rep)
#endif
      for (int uid = vcu; uid < 256; uid += G) {
        const int b = uid >> 5, h = (uid >> 3) & 3, qt = uid & 7;
        const f16* kv = KVM + (size_t)li * 2048 * 2048 + (size_t)b * NMEM * 2048 + h * 256;
        attn_unit<256, false>(lds, BIG + (size_t)(b * SEQ + qt * 256) * DM + h * 256, DM, kv, kv + DM, 2048,
                              BIG + 16 * MiB + (size_t)(b * SEQ + qt * 256) * DM + h * 256, DM, 0, nullptr, tid);
      }
    } else if (kind == K_PRO) {
      conv_layer(a, 0, scr, gw, NGW, lane); conv_layer(a, 1, scr, gw, NGW, lane);
      for (int i = 0; i < DEPTH; ++i) conv_matrix(a.in[10] + (size_t)i * DM * 2 * DM, DM, 2 * DM, BIG + 8 * MiB + (size_t)i * 2048 * DM, DM, scr, gw, NGW, lane);
      for (int r = gw; r < BATCH * NMEM; r += NGW) {
        const float* mr = a.in[1] + (size_t)r * DM + lane * 4; f32x4 v[4]; float ss = 0.f;
#pragma unroll
        for (int j = 0; j < 4; ++j) { v[j] = *(const f32x4*)(mr + 256 * j); ss += v[j][0] * v[j][0] + v[j][1] * v[j][1] + v[j][2] * v[j][2] + v[j][3] * v[j][3]; }
        const float rstd = 1.0f / sqrtf(wave_sum(ss) * (1.0f / DM) + RMS_EPS);
        for (int i = 0; i < DEPTH; ++i) {
          const float* gm = a.in[3] + (size_t)i * DM + lane * 4; f16* orow = BIG + ((size_t)i * 2048 + r) * DM + lane * 4;
#pragma unroll
          for (int j = 0; j < 4; ++j) { const f32x4 gg = *(const f32x4*)(gm + 256 * j); const f32x4 h = v[j] * rstd * gg; u32x2 w; w.x = pk_f16(h[0], h[1]); w.y = pk_f16(h[2], h[3]); *(u32x2*)(orow + 256 * j) = w; }
        }
      }
      for (int id = vcu * 512 + tid; id < SEQ * 16; id += G * 512) {
        const int pos = id >> 4, i = id & 15;
        const double rev = (double)pos * INV_FREQ[i] * 0.15915494309189535;
        const float fr = (float)(rev - (double)(long long)rev);
        ROPE[id] = __builtin_amdgcn_cosf(fr); ROPE[SEQ * 16 + id] = __builtin_amdgcn_sinf(fr);
      }
      for (int id = vcu * 512 + tid; id < 2 * 65536; id += G * 512) KMEAN[id] = 0.f;
      ew_phase(vcu, G, wave, lane, a.in[0], X, R1, nullptr, gains);
    }
    __syncthreads();
  }
}

extern "C" void kernel_launch(void* const* d_in, const int* in_sizes, int n_in, void* d_out, int out_size, void* d_ws, size_t ws_size, hipStream_t stream) {
  static int grid = 0;
  if (grid == 0) {
    int dev = 0, cus = 0, per_cu = 0;
    hipGetDevice(&dev);
    hipDeviceGetAttribute(&cus, hipDeviceAttributeMultiprocessorCount, dev);
    hipFuncSetAttribute((const void*)mega_fwd, hipFuncAttributeMaxDynamicSharedMemorySize, LDS_BYTES);
    hipOccupancyMaxActiveBlocksPerMultiprocessor(&per_cu, (const void*)mega_fwd, 512, LDS_BYTES);
    if (per_cu < 1) { fprintf(stderr, "occupancy query returned %d\n", per_cu); per_cu = 1; }
    (void)hipGetLastError();
    grid = cus;
    if (ws_size < WS_END) fprintf(stderr, "workspace too small: %zu\n", ws_size);
  }
  (void)hipMemsetAsync((char*)d_ws + WS_BAR, 0, XCD_BAR_WORDS * 4, stream);
  Args a{};
  for (int i = 0; i < 14; ++i) a.in[i] = (const float*)d_in[i];
  a.out = (float*)d_out; a.ws = (unsigned char*)d_ws;
#if MULTI_LAUNCH
  for (int ph = 0; ph < NPHASE; ++ph) { a.ph_lo = ph; a.ph_hi = ph + 1; hipLaunchKernelGGL(mega_fwd, dim3(grid), dim3(512), LDS_BYTES, stream, a); }
#else
  a.ph_lo = 0; a.ph_hi = NPHASE;
  void* args[] = {&a};
  hipError_t e = hipLaunchCooperativeKernel((const void*)mega_fwd, dim3(grid), dim3(512), args, LDS_BYTES, stream);
  if (e != hipSuccess) fprintf(stderr, "cooperative launch failed: %s (grid %d)\n", hipGetErrorString(e), grid);
#endif
}
```

```cpp
#include <hip/hip_runtime.h>
#include <hip/hip_cooperative_groups.h>
#include <cstdio>
#include <cstdint>
namespace cg = cooperative_groups;

#ifndef PROBE
#define PROBE 0
#endif
#ifndef MULTI_LAUNCH
#define MULTI_LAUNCH 0
#endif

#define LAS __attribute__((address_space(3)))
typedef _Float16 f16;
typedef _Float16 h8 __attribute__((ext_vector_type(8)));
typedef _Float16 h4 __attribute__((ext_vector_type(4)));
typedef _Float16 h2 __attribute__((ext_vector_type(2)));
typedef short s16x4 __attribute__((ext_vector_type(4)));
typedef float f32x2 __attribute__((ext_vector_type(2)));
typedef float f32x4 __attribute__((ext_vector_type(4)));
typedef float f32x16 __attribute__((ext_vector_type(16)));
typedef unsigned u32x4 __attribute__((ext_vector_type(4)));
typedef unsigned u32x2 __attribute__((ext_vector_type(2)));

constexpr int DM = 1024, BATCH = 8, SEQ = 2048, DEPTH = 4, NMEM = 256, DFF = 4096;
constexpr int M = BATCH * SEQ;
constexpr float RMS_EPS = 1e-6f;
constexpr float LOG2E = 1.4426950408889634f;

constexpr size_t MiB = 1u << 20;
constexpr size_t WS_KMEAN = 0;
constexpr size_t WS_ROPE = 512 * 1024;
constexpr size_t WS_W = 1 * MiB;
constexpr size_t WS_KVM = 60 * MiB;
constexpr size_t WS_R1 = 92 * MiB;
constexpr size_t WS_BIG = 124 * MiB;
constexpr size_t WS_END = 252 * MiB;
constexpr size_t WP_IN = 0, WP_GRP = 2 * MiB, WP_XQ = 3 * MiB, WP_XO = 5 * MiB, WP_W1 = 7 * MiB, WP_W2 = 15 * MiB;
constexpr size_t WM_QKV = 23 * MiB, WM_O = 29 * MiB, WM_XQ = 31 * MiB, WM_XO = 33 * MiB, WM_W1 = 35 * MiB, WM_W2 = 43 * MiB;

constexpr int LDS_BYTES = 131072 + 64;
constexpr size_t WS_BAR = 800 * 1024;

__device__ __forceinline__ unsigned pk_f16(float lo, float hi) { f32x2 v = {lo, hi}; h2 h = __builtin_convertvector(v, h2); return __builtin_bit_cast(unsigned, h); }
__device__ __forceinline__ float wave_sum(float v) {
#pragma unroll
  for (int o = 1; o < 64; o <<= 1) v += __shfl_xor(v, o);
  return v;
}

constexpr int BM = 256, BK = 64, HALF = 128, HTB = HALF * BK * 2, NXCD = 8, WGM = 8;
__device__ __forceinline__ int lds_byte(int r, int c) { const int st = (r >> 4) * 2 + (c >> 5), rr = r & 15, cc = c & 31, ob = rr * 64 + cc * 2; return st * 1024 + (ob ^ (((ob >> 9) & 1) << 5)); }
__device__ __forceinline__ void stage_rc(int b, int& R, int& C) { const int st = b / 1024, sb = b % 1024, swz = sb ^ (((sb >> 9) & 1) << 5); R = (st >> 1) * 16 + swz / 64; C = (st & 1) * 32 + (swz % 64) / 2; }
__device__ __forceinline__ int perm32(int rho) { const int n = rho >> 4, i = rho & 15; return 8 * (i >> 2) + 4 * n + (i & 3); }

struct Unit { int pm, pn; };
enum { EPI_F16 = 0, EPI_QKV = 1 };
enum { GM_NORMAL = 0, GM_GROUPED = 1, GM_KVM = 2 };
struct GemmDesc {
  const f16* A; const f16* Bt; int lda, ldb, K, nM, nN, mode;
  int epi, act; f16* O; int ldc; const float* colscale; float cscale;
  const float* rope; float* kmean;
};

__device__ __forceinline__ bool sched_next(const GemmDesc& g, int G, int c, int i, Unit& u) {
  const int nM = g.nM, nN = g.nN, nwg = nM * nN;
  const long L = (long)i * G + c; if (L >= nwg) return false;
  int wgid = (int)L; { const int q = nwg / NXCD, r = nwg % NXCD, xcd = wgid % NXCD, off = wgid / NXCD; wgid = (xcd < r ? xcd * (q + 1) : r * (q + 1) + (xcd - r) * q) + off; }
  const int nig = WGM * nN, gid = wgid / nig, fm = gid * WGM, gsz = (nM - fm) < WGM ? (nM - fm) : WGM;
  u.pm = fm + ((wgid % nig) % gsz); u.pn = (wgid % nig) / gsz; return true;
}

__device__ __forceinline__ void gemm_epilogue(const f32x4 (&acc)[2][2][4][2], const GemmDesc& g, const Unit& u, int wr, int wc, int fr, int fq) {
  const int row0 = u.pm * BM + wr * 64 + fr;
  const int col0 = u.pn * BM + wc * 32 + 8 * fq;
  if (g.epi == EPI_F16) {
    float cs[2][8];
#pragma unroll
    for (int bj = 0; bj < 2; ++bj) {
      if (g.colscale) { const f32x4 a = *(const f32x4*)(g.colscale + col0 + bj * HALF), b = *(const f32x4*)(g.colscale + col0 + bj * HALF + 4);
        cs[bj][0] = a[0] * g.cscale; cs[bj][1] = a[1] * g.cscale; cs[bj][2] = a[2] * g.cscale; cs[bj][3] = a[3] * g.cscale;
        cs[bj][4] = b[0] * g.cscale; cs[bj][5] = b[1] * g.cscale; cs[bj][6] = b[2] * g.cscale; cs[bj][7] = b[3] * g.cscale;
      } else {
#pragma unroll
        for (int e = 0; e < 8; ++e) cs[bj][e] = g.cscale;
      }
    }
    const bool act = g.act != 0;
#pragma unroll
    for (int ai = 0; ai < 2; ++ai)
#pragma unroll
      for (int m = 0; m < 4; ++m) {
        f16* rowp = g.O + (size_t)(row0 + ai * HALF + m * 16) * g.ldc + col0;
#pragma unroll
        for (int bj = 0; bj < 2; ++bj) {
          f32x4 v0 = acc[ai][bj][m][0], v1 = acc[ai][bj][m][1];
          if (act) {
#pragma unroll
            for (int e = 0; e < 4; ++e) { float a = fmaxf(v0[e], 0.f); v0[e] = a * a; float b = fmaxf(v1[e], 0.f); v1[e] = b * b; }
          }
          u32x4 w;
          w.x = pk_f16(v0[0] * cs[bj][0], v0[1] * cs[bj][1]); w.y = pk_f16(v0[2] * cs[bj][2], v0[3] * cs[bj][3]);
          w.z = pk_f16(v1[0] * cs[bj][4], v1[1] * cs[bj][5]); w.w = pk_f16(v1[2] * cs[bj][6], v1[3] * cs[bj][7]);
          *(u32x4*)(rowp + bj * HALF) = w;
        }
      }
  } else {
    const int which = u.pn >> 2;
    const bool dorope = (which < 2) && (wc == 0);
    const float qs = (which == 0) ? g.cscale : 1.f;
    float ksum[2][8];
#pragma unroll
    for (int bj = 0; bj < 2; ++bj)
#pragma unroll
      for (int e = 0; e < 8; ++e) ksum[bj][e] = 0.f;
#pragma unroll
    for (int ai = 0; ai < 2; ++ai)
#pragma unroll
      for (int m = 0; m < 4; ++m) {
        const int row = row0 + ai * HALF + m * 16;
        f16* rowp = g.O + (size_t)row * g.ldc + col0;
        float cv[8], sv[8];
        if (dorope) {
          const float* rp = g.rope + (size_t)(row & (SEQ - 1)) * 16 + 8 * (fq & 1);
          const f32x4 c0 = *(const f32x4*)rp, c1 = *(const f32x4*)(rp + 4), s0 = *(const f32x4*)(rp + SEQ * 16), s1 = *(const f32x4*)(rp + SEQ * 16 + 4);
          const float sg = (fq < 2) ? -1.f : 1.f;
#pragma unroll
          for (int e = 0; e < 4; ++e) { cv[e] = c0[e]; cv[4 + e] = c1[e]; sv[e] = s0[e] * sg; sv[4 + e] = s1[e] * sg; }
        }
#pragma unroll
        for (int bj = 0; bj < 2; ++bj) {
          float v[8];
#pragma unroll
          for (int e = 0; e < 4; ++e) { v[e] = acc[ai][bj][m][0][e]; v[4 + e] = acc[ai][bj][m][1][e]; }
          if (dorope) {
#pragma unroll
            for (int e = 0; e < 8; ++e) { const float p = __shfl_xor(v[e], 32); v[e] = v[e] * cv[e] + p * sv[e]; }
          }
          if (which == 1) {
#pragma unroll
            for (int e = 0; e < 8; ++e) ksum[bj][e] += v[e];
          }
          u32x4 w;
          w.x = pk_f16(v[0] * qs, v[1] * qs); w.y = pk_f16(v[2] * qs, v[3] * qs); w.z = pk_f16(v[4] * qs, v[5] * qs); w.w = pk_f16(v[6] * qs, v[7] * qs);
          *(u32x4*)(rowp + bj * HALF) = w;
        }
      }
    if (which == 1 && g.kmean) {
      const int b = u.pm >> 3, blk = u.pm & 7;
#pragma unroll
      for (int bj = 0; bj < 2; ++bj) {
        const int head = 2 * (u.pn & 3) + bj;
        float* kp = g.kmean + ((size_t)((b * 8 + head) * 8 + blk)) * 128 + wc * 32 + 8 * fq;
#pragma unroll
        for (int e = 0; e < 8; ++e) {
          float s = ksum[bj][e];
          s += __shfl_xor(s, 1); s += __shfl_xor(s, 2); s += __shfl_xor(s, 4); s += __shfl_xor(s, 8);
          if (fr == 0) atomicAdd(kp + e, s);
        }
      }
    }
  }
}

__device__ __forceinline__ void gemm_phase(LAS unsigned char* lds, const GemmDesc& g, int G, int c, const int tid) {
  const int wid = __builtin_amdgcn_readfirstlane(tid >> 6), lane = tid & 63, wr = wid >> 2, wc = wid & 3, fr = lane & 15, fq = lane >> 4;
  const int K = g.K, nt = K / BK;
  unsigned voffA[2], voffB[2];
#pragma unroll
  for (int i = 0; i < 2; ++i) { int R, C; stage_rc(tid * 16 + i * 8192, R, C); const int Rb = (R & ~31) + perm32(R & 31);
    voffA[i] = (unsigned)(R * g.lda + C) * 2u; voffB[i] = (unsigned)(Rb * g.ldb + C) * 2u; }
  const size_t kstep = (size_t)(BK * 2);
  const size_t hstepA = (size_t)HALF * g.lda * 2, hstepB = (size_t)HALF * g.ldb * 2;
  const size_t tstepA = 2 * hstepA, tstepB = 2 * hstepB;
  const unsigned ldsw = (unsigned)wid * 1024u;
  const int aoff = lds_byte(wr * 64 + fr, fq * 8), boff = lds_byte(wc * 32 + fr, fq * 8);
#define UA(u) ((size_t)(u).pm * tstepA + (g.mode == GM_GROUPED ? (size_t)(u).pn * 512 : 0))
#define UB(u) ((size_t)(g.mode == GM_KVM ? (((u).pm >> 3) * 8 + (u).pn) : (u).pn) * tstepB)
#define PG8_SA(b, h) (((b) * 2 + (h)) * HTB)
#define PG8_SB(b, h) ((4 + (b) * 2 + (h)) * HTB)
#define PG8_STAGE(bufoff, gbase, voff) do { _Pragma("unroll") for (int _i = 0; _i < 2; ++_i) \
    __builtin_amdgcn_global_load_lds((const unsigned*)((const char*)(gbase) + (voff)[_i]), (LAS unsigned*)(lds + (bufoff) + ldsw + _i * 8192), 16, 0, 0); } while (0)
#define PG8_LDA(dst, b, h) do { _Pragma("unroll") for (int m = 0; m < 4; ++m) _Pragma("unroll") for (int k = 0; k < 2; ++k) dst[m][k] = *(const LAS h8*)(lds + PG8_SA(b, h) + aoff + m * 2048 + k * 1024); } while (0)
#define PG8_LDB(dst, b, h) do { _Pragma("unroll") for (int n = 0; n < 2; ++n) _Pragma("unroll") for (int k = 0; k < 2; ++k) dst[n][k] = *(const LAS h8*)(lds + PG8_SB(b, h) + boff + n * 2048 + k * 1024); } while (0)
#define PG8_MMA(ai, bj, At, Bt) do { __builtin_amdgcn_s_setprio(1); _Pragma("unroll") for (int m = 0; m < 4; ++m) _Pragma("unroll") for (int n = 0; n < 2; ++n) _Pragma("unroll") for (int k = 0; k < 2; ++k) \
    acc[ai][bj][m][n] = __builtin_amdgcn_mfma_f32_16x16x32_f16(Bt[n][k], At[m][k], acc[ai][bj][m][n], 0, 0, 0); __builtin_amdgcn_s_setprio(0); } while (0)
#define PG8_WAIT_V(n) asm volatile("s_waitcnt vmcnt(" #n ")" ::: "memory")
#define PG8_WAIT_L(n) asm volatile("s_waitcnt lgkmcnt(" #n ")" ::: "memory")
#define PG8_BAR __builtin_amdgcn_s_barrier()
#define PG8_SCHED __builtin_amdgcn_sched_barrier(0)
  Unit cur, nxt; int ui = 0;
  if (!sched_next(g, G, c, 0, cur)) return;
  f32x4 acc[2][2][4][2];
#pragma unroll
  for (int a = 0; a < 2; ++a)
#pragma unroll
    for (int b = 0; b < 2; ++b)
#pragma unroll
      for (int m = 0; m < 4; ++m)
#pragma unroll
        for (int n = 0; n < 2; ++n) acc[a][b][m][n] = (f32x4){0.f, 0.f, 0.f, 0.f};
  h8 At[4][2], B0[2][2], B1[2][2];
  const char* cA = (const char*)g.A + UA(cur); const char* cB = (const char*)g.Bt + UB(cur);
  PG8_STAGE(PG8_SB(0, 0), cB, voffB); PG8_STAGE(PG8_SB(0, 1), cB + hstepB, voffB); PG8_STAGE(PG8_SA(0, 0), cA, voffA); PG8_STAGE(PG8_SA(0, 1), cA + hstepA, voffA);
  if (wr == 1) PG8_BAR;
  PG8_WAIT_V(2); PG8_BAR;
  PG8_STAGE(PG8_SB(1, 0), cB + kstep, voffB); PG8_STAGE(PG8_SA(1, 0), cA + kstep, voffA); PG8_STAGE(PG8_SB(1, 1), cB + hstepB + kstep, voffB);
  PG8_WAIT_V(6); PG8_BAR;
  for (;;) {
    const bool has_next = sched_next(g, G, c, ui + 1, nxt);
    const char* nA = has_next ? (const char*)g.A + UA(nxt) : cA; const char* nB = has_next ? (const char*)g.Bt + UB(nxt) : cB;
    for (int t = 0; t < nt; t += 2) {
      const bool last = (t == nt - 2);
      const char* a1 = cA + (size_t)(t + 1) * kstep;
      const char* a2 = last ? nA : cA + (size_t)(t + 2) * kstep; const char* b2 = last ? nB : cB + (size_t)(t + 2) * kstep;
      const char* a3 = a2 + kstep; const char* b3 = b2 + kstep;
      PG8_LDB(B0, 0, 0); PG8_LDB(B1, 0, 1); PG8_SCHED; PG8_LDA(At, 0, 0); PG8_STAGE(PG8_SA(1, 1), a1 + hstepA, voffA);
      PG8_WAIT_V(8); PG8_WAIT_L(0); PG8_BAR; PG8_MMA(0, 0, At, B0); PG8_MMA(0, 1, At, B1); PG8_BAR; PG8_SCHED;
      PG8_LDA(At, 0, 1); PG8_STAGE(PG8_SB(0, 0), b2, voffB); PG8_STAGE(PG8_SB(0, 1), b2 + hstepB, voffB); PG8_STAGE(PG8_SA(0, 0), a2, voffA);
      PG8_WAIT_V(8); PG8_WAIT_L(0); PG8_BAR; PG8_MMA(1, 0, At, B0); PG8_MMA(1, 1, At, B1); PG8_BAR; PG8_SCHED;
      PG8_LDB(B0, 1, 0); PG8_LDB(B1, 1, 1); PG8_SCHED; PG8_LDA(At, 1, 0); PG8_STAGE(PG8_SA(0, 1), a2 + hstepA, voffA);
      PG8_WAIT_V(8); PG8_WAIT_L(0); PG8_BAR; PG8_MMA(0, 0, At, B0); PG8_MMA(0, 1, At, B1); PG8_BAR; PG8_SCHED;
      PG8_LDA(At, 1, 1); PG8_STAGE(PG8_SB(1, 0), b3, voffB); PG8_STAGE(PG8_SB(1, 1), b3 + hstepB, voffB); PG8_STAGE(PG8_SA(1, 0), a3, voffA);
      PG8_WAIT_V(8); PG8_WAIT_L(0); PG8_BAR; PG8_MMA(1, 0, At, B0); PG8_MMA(1, 1, At, B1); PG8_BAR; PG8_SCHED;
    }
    if (wr == 0) PG8_BAR;
    gemm_epilogue(acc, g, cur, wr, wc, fr, fq);
    if (!has_next) break;
#pragma unroll
    for (int a = 0; a < 2; ++a)
#pragma unroll
      for (int b = 0; b < 2; ++b)
#pragma unroll
        for (int m = 0; m < 4; ++m)
#pragma unroll
          for (int n = 0; n < 2; ++n) acc[a][b][m][n] = (f32x4){0.f, 0.f, 0.f, 0.f};
    cur = nxt; cA = nA; cB = nB; ++ui;
    if (wr == 1) PG8_BAR;
  }
  PG8_WAIT_V(0);
  PG8_BAR;
#undef UA
#undef UB
#undef PG8_SA
#undef PG8_SB
#undef PG8_STAGE
#undef PG8_LDA
#undef PG8_LDB
#undef PG8_MMA
#undef PG8_WAIT_V
#undef PG8_WAIT_L
#undef PG8_BAR
#undef PG8_SCHED
}

__device__ __forceinline__ s16x4 vtr(const LAS unsigned char* p) { return __builtin_amdgcn_ds_read_tr16_b64_v4i16((LAS s16x4*)p); }

template <int HD, bool MOBA>
__device__ __forceinline__ void attn_unit(LAS unsigned char* lds, const f16* Qg, int ldq, const f16* Kg, const f16* Vg, int ldkv,
                                          f16* Og, int ldo, int qb, const float* kmg, const int tid) {
  constexpr int KS = HD * 2 + 16, VS = 320, KT_BYTES = 64 * KS, VT_BYTES = 64 * VS;
  constexpr int NSTEP = HD / 16, NPASS = HD / 128, KCH = HD / 8, KPT = 64 * KCH / 512, VPT = 2;
  constexpr int BUFB = KT_BYTES + VT_BYTES;
  LAS unsigned char* Kl = lds; LAS unsigned char* Vl = lds + KT_BYTES; LAS float* kml = (LAS float*)(lds + 2 * BUFB);
  const int lane = tid & 63, wid = __builtin_amdgcn_readfirstlane(tid >> 6), r32 = lane & 31, hi = lane >> 5;
  const float NEG = -INFINITY;
  constexpr bool QREG = (HD == 128);
  constexpr int NQF = QREG ? NSTEP : 1;
  h8 qf[NQF];
  const f16* qrow = Qg + (size_t)(wid * 32 + r32) * ldq + hi * 8;
  if (QREG) {
#pragma unroll
    for (int s = 0; s < NQF; ++s) qf[s] = *(const h8*)(qrow + s * 16); }
  unsigned selmask = 0;
  if (MOBA) {
    for (int idx = tid; idx < qb * 128; idx += 512) kml[idx] = kmg[idx];
    __syncthreads();
    float gate[7];
#pragma unroll
    for (int j = 0; j < 7; ++j) {
      gate[j] = NEG;
      if (j < qb) {
        float a = 0.f;
#pragma unroll
        for (int s = 0; s < NSTEP; ++s) {
          const f32x4 k0 = *(const LAS f32x4*)(kml + j * 128 + s * 16 + hi * 8), k1 = *(const LAS f32x4*)(kml + j * 128 + s * 16 + hi * 8 + 4);
          a += (float)qf[s][0] * k0[0] + (float)qf[s][1] * k0[1] + (float)qf[s][2] * k0[2] + (float)qf[s][3] * k0[3]
             + (float)qf[s][4] * k1[0] + (float)qf[s][5] * k1[1] + (float)qf[s][6] * k1[2] + (float)qf[s][7] * k1[3];
        }
        a += __shfl_xor(a, 32);
        gate[j] = a;
      }
    }
    if (qb <= 3) selmask = (1u << qb) - 1u;
    else {
#pragma unroll
      for (int rnd = 0; rnd < 3; ++rnd) {
        float best = NEG; int bi = 0;
#pragma unroll
        for (int j = 0; j < 7; ++j) { const bool ok = (j < qb) && !((selmask >> j) & 1u) && (gate[j] > best); if (ok) { best = gate[j]; bi = j; } }
        selmask |= 1u << bi;
      }
    }
  }
  const int NT = MOBA ? 4 * (qb + 1) : 4;
  const LAS unsigned char* kb0 = Kl + r32 * KS + hi * 16;
  const LAS unsigned char* vb0 = Vl + (((lane & 15) >> 2) + 4 * hi) * VS + (16 * ((lane >> 4) & 1) + 4 * (lane & 3)) * 2;
#pragma unroll 1
  for (int pass = 0; pass < NPASS; ++pass) {
    f32x16 o[4];
#pragma unroll
    for (int d = 0; d < 4; ++d)
#pragma unroll
      for (int r = 0; r < 16; ++r) o[d][r] = 0.f;
    float m_run = NEG, l_run = 0.f;
    u32x4 kreg[KPT], vreg[VPT];
#define ATT_KEY0(t) (MOBA ? (((t) < 4 ? qb : (((t) - 4) >> 2)) * 256 + ((t) & 3) * 64) : (t) * 64)
#define ATT_LOAD(t) do { const int key0_ = ATT_KEY0(t); int tid_ = tid; asm volatile("" : "+v"(tid_)); \
      _Pragma("unroll") for (int i = 0; i < KPT; ++i) { const int id = tid_ + 512 * i, row = id / KCH, ch = id % KCH; kreg[i] = *(const u32x4*)(Kg + (size_t)(key0_ + row) * ldkv + ch * 8); } \
      _Pragma("unroll") for (int i = 0; i < VPT; ++i) { const int id = tid_ + 512 * i, row = id >> 4, ch = id & 15; vreg[i] = *(const u32x4*)(Vg + pass * 128 + (size_t)(key0_ + row) * ldkv + ch * 8); } } while (0)
#define ATT_STORE(bo) do { \
      _Pragma("unroll") for (int i = 0; i < KPT; ++i) { const int id = tid + 512 * i, row = id / KCH, ch = id % KCH; *(LAS u32x4*)(Kl + (bo) + row * KS + ch * 16) = kreg[i]; } \
      _Pragma("unroll") for (int i = 0; i < VPT; ++i) { const int id = tid + 512 * i, row = id >> 4, ch = id & 15; *(LAS u32x4*)(Vl + (bo) + row * VS + ch * 16) = vreg[i]; } } while (0)
    ATT_LOAD(0);
    ATT_STORE(0);
    if (NT > 1) ATT_LOAD(1);
    __syncthreads();
#pragma unroll 1
    for (int t = 0; t < NT; ++t) {
      const int bo = (t & 1) * BUFB;
      const LAS unsigned char* kb = kb0 + bo; const LAS unsigned char* vb = vb0 + bo;
      const int blk = MOBA ? (t < 4 ? qb : ((t - 4) >> 2)) : 0, kt = t & 3;
      const bool own = MOBA && (t < 4);
      bool need = true;
      if (MOBA) { if (own) need = (kt <= (wid >> 1)); else need = (__ballot((selmask >> blk) & 1u) != 0ull); }
      if (need) {
        f32x16 p0, p1;
#pragma unroll
        for (int r = 0; r < 16; ++r) { p0[r] = 0.f; p1[r] = 0.f; }
        const f16* qr = qrow; if (!QREG) asm volatile("" : "+v"(qr));
#pragma unroll
        for (int s = 0; s < NSTEP; ++s) {
          const h8 k0 = *(const LAS h8*)(kb + s * 32), k1 = *(const LAS h8*)(kb + 32 * KS + s * 32);
          const h8 q = QREG ? qf[QREG ? s : 0] : *(const h8*)(qr + s * 16);
          p0 = __builtin_amdgcn_mfma_f32_32x32x16_f16(k0, q, p0, 0, 0, 0);
          p1 = __builtin_amdgcn_mfma_f32_32x32x16_f16(k1, q, p1, 0, 0, 0);
        }
        if (MOBA) {
          if (own) {
            const int qpos = wid * 32 + r32, kbase = kt * 64 + 4 * hi;
#pragma unroll
            for (int r = 0; r < 16; ++r) { const int kv = kbase + (r & 3) + 8 * (r >> 2); if (kv > qpos) p0[r] = NEG; if (kv + 32 > qpos) p1[r] = NEG; }
          } else if (!((selmask >> blk) & 1u)) {
#pragma unroll
            for (int r = 0; r < 16; ++r) { p0[r] = NEG; p1[r] = NEG; }
          }
        }
        float mx = fmaxf(p0[0], p1[0]);
#pragma unroll
        for (int r = 1; r < 16; ++r) mx = fmaxf(mx, fmaxf(p0[r], p1[r]));
        mx = fmaxf(mx, __shfl_xor(mx, 32));
        const float m_new = fmaxf(m_run, mx);
        const float alpha = __builtin_amdgcn_exp2f(m_run - m_new);
        m_run = m_new;
        float ps = 0.f;
#pragma unroll
        for (int r = 0; r < 16; ++r) { p0[r] = __builtin_amdgcn_exp2f(p0[r] - m_new); p1[r] = __builtin_amdgcn_exp2f(p1[r] - m_new); ps += p0[r] + p1[r]; }
        l_run = l_run * alpha + ps;
#pragma unroll
        for (int d = 0; d < 4; ++d)
#pragma unroll
          for (int r = 0; r < 16; ++r) o[d][r] *= alpha;
        h8 pf[4];
        { u32x4 w;
          w.x = pk_f16(p0[0], p0[1]); w.y = pk_f16(p0[2], p0[3]); w.z = pk_f16(p0[4], p0[5]); w.w = pk_f16(p0[6], p0[7]); pf[0] = __builtin_bit_cast(h8, w);
          w.x = pk_f16(p0[8], p0[9]); w.y = pk_f16(p0[10], p0[11]); w.z = pk_f16(p0[12], p0[13]); w.w = pk_f16(p0[14], p0[15]); pf[1] = __builtin_bit_cast(h8, w);
          w.x = pk_f16(p1[0], p1[1]); w.y = pk_f16(p1[2], p1[3]); w.z = pk_f16(p1[4], p1[5]); w.w = pk_f16(p1[6], p1[7]); pf[2] = __builtin_bit_cast(h8, w);
          w.x = pk_f16(p1[8], p1[9]); w.y = pk_f16(p1[10], p1[11]); w.z = pk_f16(p1[12], p1[13]); w.w = pk_f16(p1[14], p1[15]); pf[3] = __builtin_bit_cast(h8, w); }
#pragma unroll
        for (int d = 0; d < 4; ++d)
#pragma unroll
          for (int s = 0; s < 4; ++s) {
            const s16x4 lo = vtr(vb + (16 * s) * VS + d * 64), hh = vtr(vb + (16 * s + 8) * VS + d * 64);
            typedef short s16x8 __attribute__((ext_vector_type(8)));
            const s16x8 av = {lo[0], lo[1], lo[2], lo[3], hh[0], hh[1], hh[2], hh[3]};
            o[d] = __builtin_amdgcn_mfma_f32_32x32x16_f16(__builtin_bit_cast(h8, av), pf[s], o[d], 0, 0, 0);
          }
      }
      if (t + 1 < NT) { ATT_STORE(BUFB - bo); if (t + 2 < NT) ATT_LOAD(t + 2); }
      __syncthreads();
    }
#undef ATT_LOAD
#undef ATT_STORE
#undef ATT_KEY0
    const float l = l_run + __shfl_xor(l_run, 32);
    const float inv = 1.0f / l;
    f16* orow = Og + (size_t)(wid * 32 + r32) * ldo + pass * 128 + 4 * hi;
#pragma unroll
    for (int d = 0; d < 4; ++d)
#pragma unroll
      for (int rg = 0; rg < 4; ++rg) {
        u32x2 w; w.x = pk_f16(o[d][4 * rg] * inv, o[d][4 * rg + 1] * inv); w.y = pk_f16(o[d][4 * rg + 2] * inv, o[d][4 * rg + 3] * inv);
        *(u32x2*)(orow + 32 * d + 8 * rg) = w;
      }
  }
}


#define XB_TMO      128
#define XB_XCNT(j)  (256  + 64 * (j))
#define XB_XSUB(j)  (1280 + 64 * (j))
#define XB_XGEN(j)  (2304 + 64 * (j))
#define XB_TOP      3328
#define XB_TOPGEN   3392
#define XCD_BAR_WORDS 3456
#define XB_SPIN_CAP (1u << 22)
__device__ __forceinline__ unsigned xb_ld(unsigned* p)              { return __hip_atomic_load(p, __ATOMIC_RELAXED, __HIP_MEMORY_SCOPE_AGENT); }
__device__ __forceinline__ unsigned xb_add(unsigned* p, unsigned v) { return __hip_atomic_fetch_add(p, v, __ATOMIC_RELAXED, __HIP_MEMORY_SCOPE_AGENT); }
__device__ __forceinline__ unsigned xb_xcc_id() { return (unsigned)__builtin_amdgcn_s_getreg((3 << 11) | 20) & 0xFu; }
#define XB_SPIN(cond, bar) do { unsigned _sp = 0; while (cond) { __builtin_amdgcn_s_sleep(1); \
    if ((++_sp & 255u) == 0u) { if (xb_ld(&(bar)[XB_TMO])) break; if (_sp > XB_SPIN_CAP) { atomicAdd(&(bar)[XB_TMO], 1u); break; } } } } while (0)
struct XcdBarrier { unsigned* bar; unsigned x; volatile LAS unsigned* st; };
__device__ __forceinline__ XcdBarrier xcd_barrier_post(unsigned* bar, volatile LAS unsigned* st) {
  XcdBarrier b; b.bar = bar; b.x = xb_xcc_id(); b.st = st;
  if (threadIdx.x == 0) (void)xb_add(&bar[XB_XCNT(b.x)], 1u);
  return b;
}
__device__ __forceinline__ void xcd_barrier_complete(unsigned* bar, unsigned x, unsigned& nloc, unsigned& nx) {
  const unsigned G = gridDim.x * gridDim.y * gridDim.z;
  unsigned sum, cnt, mine, sp = 0u;
  for (;;) {
    sum = 0u; cnt = 0u; mine = 0u;
#pragma unroll
    for (unsigned j = 0; j < 16; ++j) { const unsigned c = xb_ld(&bar[XB_XCNT(j)]); sum += c; cnt += (c > 0u) ? 1u : 0u; mine = (j == x) ? c : mine; }
    if (sum == G) break;
    __builtin_amdgcn_s_sleep(1);
    if ((++sp & 255u) == 0u) { if (xb_ld(&bar[XB_TMO])) break; if (sp > XB_SPIN_CAP) { atomicAdd(&bar[XB_TMO], 1u); break; } }
  }
  nloc = mine > 0u ? mine : 1u; nx = cnt > 0u ? cnt : 1u;
}
__device__ __forceinline__ void xcd_barrier(const XcdBarrier& b) {
  asm volatile("s_waitcnt vmcnt(0)" ::: "memory");
  __syncthreads();
  if (threadIdx.x == 0) {
    unsigned* bar = b.bar;
    __builtin_amdgcn_s_waitcnt(0);
    unsigned nloc = b.st[0], nx = b.st[1];
    if (nloc == 0u) { xcd_barrier_complete(bar, b.x, nloc, nx); b.st[0] = nloc; b.st[1] = nx; }
    const unsigned old = xb_add(&bar[XB_XSUB(b.x)], 1u);
    const unsigned gen = old / nloc;
    if (old + 1u == (gen + 1u) * nloc) {
      __builtin_amdgcn_fence(__ATOMIC_RELEASE, "agent");
      asm volatile("s_waitcnt vmcnt(0)" ::: "memory");
      const unsigned og = xb_add(&bar[XB_TOP], 1u);
      const unsigned tg = og / nx;
      if (og + 1u == (tg + 1u) * nx) xb_add(&bar[XB_TOPGEN], 1u);
      else XB_SPIN(xb_ld(&bar[XB_TOPGEN]) == tg, bar);
      __builtin_amdgcn_fence(__ATOMIC_ACQUIRE, "agent");
      xb_add(&bar[XB_XGEN(b.x)], 1u);
      asm volatile("s_waitcnt vmcnt(0)" ::: "memory");
    } else {
      XB_SPIN(xb_ld(&bar[XB_XGEN(b.x)]) == gen, bar);
      __builtin_amdgcn_fence(__ATOMIC_ACQUIRE, "agent");
      asm volatile("s_waitcnt vmcnt(0)" ::: "memory");
    }
  }
  __syncthreads();
}

__device__ __forceinline__ void ew_phase(int vcu, int G, int wave, int lane, const float* xin, float* X, f16* R1, const float* gpost, const float* gpre) {
  f32x4 gp[4], gq[4];
#pragma unroll
  for (int j = 0; j < 4; ++j) { gp[j] = gpost ? *(const f32x4*)(gpost + lane * 4 + 256 * j) : (f32x4){0.f, 0.f, 0.f, 0.f}; gq[j] = gpre ? *(const f32x4*)(gpre + lane * 4 + 256 * j) : (f32x4){0.f, 0.f, 0.f, 0.f}; }
  for (int m = vcu * 8 + wave; m < M; m += G * 8) {
    const float* xr = (xin ? xin : X) + (size_t)m * DM + lane * 4;
    f16* rr = R1 + (size_t)m * DM + lane * 4;
    f32x4 xv[4];
#pragma unroll
    for (int j = 0; j < 4; ++j) xv[j] = *(const f32x4*)(xr + 256 * j);
    if (gpost) {
      f32x4 yv[4]; float ss = 0.f;
#pragma unroll
      for (int j = 0; j < 4; ++j) { const h4 y = *(const h4*)(rr + 256 * j); yv[j] = (f32x4){(float)y[0], (float)y[1], (float)y[2], (float)y[3]}; ss += yv[j][0] * yv[j][0] + yv[j][1] * yv[j][1] + yv[j][2] * yv[j][2] + yv[j][3] * yv[j][3]; }
      const float rstd = 1.0f / sqrtf(wave_sum(ss) * (1.0f / DM) + RMS_EPS);
#pragma unroll
      for (int j = 0; j < 4; ++j) xv[j] = xv[j] + yv[j] * rstd * gp[j];
    }
    float* xo = X + (size_t)m * DM + lane * 4;
#pragma unroll
    for (int j = 0; j < 4; ++j) *(f32x4*)(xo + 256 * j) = xv[j];
    if (gpre) {
      float ss = 0.f;
#pragma unroll
      for (int j = 0; j < 4; ++j) ss += xv[j][0] * xv[j][0] + xv[j][1] * xv[j][1] + xv[j][2] * xv[j][2] + xv[j][3] * xv[j][3];
      const float rstd = 1.0f / sqrtf(wave_sum(ss) * (1.0f / DM) + RMS_EPS);
#pragma unroll
      for (int j = 0; j < 4; ++j) { const f32x4 h = xv[j] * rstd * gq[j]; u32x2 w; w.x = pk_f16(h[0], h[1]); w.y = pk_f16(h[2], h[3]); *(u32x2*)(rr + 256 * j) = w; }
    }
  }
}

__device__ __forceinline__ void pool_phase(int vcu, int G, const f16* U, f16* P, const int tid) {
  for (int id = vcu * 512 + tid; id < (M / 16) * 128; id += G * 512) {
    const int chunk = id & 127, run = id >> 7, grp = chunk >> 5, w = 2 << grp;
    const int row0 = run * 16, t0 = row0 & (SEQ - 1);
    const f16* up = U + (size_t)row0 * DM + chunk * 8;
    f16* pp = P + (size_t)row0 * DM + chunk * 8;
    float sum[8];
#pragma unroll
    for (int e = 0; e < 8; ++e) sum[e] = 0.f;
    for (int k = 1; k < w; ++k) {
      if (t0 - k >= 0) { const h8 v = *(const h8*)(up - (size_t)k * DM);
#pragma unroll
        for (int e = 0; e < 8; ++e) sum[e] += (float)v[e]; }
    }
    for (int i = 0; i < 16; ++i) {
      const int t = t0 + i;
      const h8 cur = *(const h8*)(up + (size_t)i * DM);
      const float rc = 1.0f / (float)(t + 1 < w ? t + 1 : w);
      float o[8];
#pragma unroll
      for (int e = 0; e < 8; ++e) { sum[e] += (float)cur[e]; o[e] = sum[e] * rc - (float)cur[e]; }
      u32x4 wv; wv.x = pk_f16(o[0], o[1]); wv.y = pk_f16(o[2], o[3]); wv.z = pk_f16(o[4], o[5]); wv.w = pk_f16(o[6], o[7]);
      *(u32x4*)(pp + (size_t)i * DM) = wv;
      if (t - w + 1 >= 0) { const h8 old = *(const h8*)(up + (size_t)(i - w + 1) * DM);
#pragma unroll
        for (int e = 0; e < 8; ++e) sum[e] -= (float)old[e]; }
    }
  }
}

__device__ __forceinline__ void conv_matrix(const float* W, int K, int N, f16* WT, int ldk, int& off, int gw, int NGW, int lane) {
  const int nblk = N / 64, nitems = (K / 64) * nblk;
  int first = gw - (off % NGW); if (first < 0) first += NGW;
  for (int item = first; item < nitems; item += NGW) {
    const int kb = item / nblk, nb = item % nblk, k0 = 64 * kb, n = 64 * nb + lane;
    const float* src = W + (size_t)k0 * N + n;
    f16* dst = WT + (size_t)n * ldk + k0;
#pragma unroll
    for (int hb = 0; hb < 2; ++hb) {
      float v[32];
#pragma unroll
      for (int j = 0; j < 32; ++j) v[j] = src[(size_t)(hb * 32 + j) * N];
#pragma unroll
      for (int q = 0; q < 4; ++q) { u32x4 o; o.x = pk_f16(v[8 * q], v[8 * q + 1]); o.y = pk_f16(v[8 * q + 2], v[8 * q + 3]); o.z = pk_f16(v[8 * q + 4], v[8 * q + 5]); o.w = pk_f16(v[8 * q + 6], v[8 * q + 7]);
        *(u32x4*)(dst + hb * 32 + 8 * q) = o; }
    }
  }
  off += nitems;
}

__device__ const double INV_FREQ[16] = {
  1.0, 0.44036660267178046, 0.19392274474868576, 0.08539710028576561, 0.03760603093086393, 0.016560440080994446,
  0.007292664737217109, 0.003211445994752591, 0.001414213562373095, 0.000622772421914596, 0.0002742481756762073,
  0.00012076973741146504, 5.318295896944988e-05, 2.341999896140934e-05, 1.031338537721246e-05, 4.5416704806078695e-06 };

struct Args { const float* in[14]; float* out; unsigned char* ws; int ph_lo, ph_hi; };

__device__ __forceinline__ void conv_layer(const Args& a, int i, int& scr, int gw, int NGW, int lane) {
  unsigned char* wb = a.ws + WS_W; const int j = i >> 1;
  if ((i & 1) == 0) {
    conv_matrix(a.in[4] + (size_t)j * DM * DM, DM, DM, (f16*)(wb + WP_IN), DM, scr, gw, NGW, lane);
    for (int g = 0; g < 4; ++g) conv_matrix(a.in[5] + (size_t)(j * 4 + g) * 65536, 256, 256, (f16*)(wb + WP_GRP) + g * 65536, 256, scr, gw, NGW, lane);
    conv_matrix(a.in[9] + (size_t)i * DM * DM, DM, DM, (f16*)(wb + WP_XQ), DM, scr, gw, NGW, lane);
    conv_matrix(a.in[11] + (size_t)i * DM * DM, DM, DM, (f16*)(wb + WP_XO), DM, scr, gw, NGW, lane);
    conv_matrix(a.in[12] + (size_t)i * DM * DFF, DM, DFF, (f16*)(wb + WP_W1), DM, scr, gw, NGW, lane);
    conv_matrix(a.in[13] + (size_t)i * DFF * DM, DFF, DM, (f16*)(wb + WP_W2), DFF, scr, gw, NGW, lane);
  } else {
    conv_matrix(a.in[7] + (size_t)j * DM * 3 * DM, DM, 3 * DM, (f16*)(wb + WM_QKV), DM, scr, gw, NGW, lane);
    conv_matrix(a.in[8] + (size_t)j * DM * DM, DM, DM, (f16*)(wb + WM_O), DM, scr, gw, NGW, lane);
    conv_matrix(a.in[9] + (size_t)i * DM * DM, DM, DM, (f16*)(wb + WM_XQ), DM, scr, gw, NGW, lane);
    conv_matrix(a.in[11] + (size_t)i * DM * DM, DM, DM, (f16*)(wb + WM_XO), DM, scr, gw, NGW, lane);
    conv_matrix(a.in[12] + (size_t)i * DM * DFF, DM, DFF, (f16*)(wb + WM_W1), DM, scr, gw, NGW, lane);
    conv_matrix(a.in[13] + (size_t)i * DFF * DM, DFF, DM, (f16*)(wb + WM_W2), DFF, scr, gw, NGW, lane);
  }
}

constexpr int NPHASE = 2 + 11 * DEPTH;

__global__ void __launch_bounds__(512, 2) mega_fwd(Args a) {
  extern __shared__ __attribute__((aligned(16))) unsigned char lds_raw[];
  LAS unsigned char* lds = (LAS unsigned char*)lds_raw;
  const int G = gridDim.x, bx = blockIdx.x;
  const int vcu = (G % 8 == 0) ? (bx % 8) * (G / 8) + bx / 8 : bx;
  const int NGW = G * 8;
  unsigned char* ws = a.ws;
  float* X = a.out;
  f16* R1 = (f16*)(ws + WS_R1);
  f16* BIG = (f16*)(ws + WS_BIG);
  f16* KVM = (f16*)(ws + WS_KVM);
  float* KMEAN = (float*)(ws + WS_KMEAN);
  float* ROPE = (float*)(ws + WS_ROPE);
  const float* gains = a.in[2];

  volatile LAS unsigned* MISC = (volatile LAS unsigned*)(lds + 131072);
  if (threadIdx.x < 16) MISC[threadIdx.x] = 0u;
  __syncthreads();
  const XcdBarrier xbar = xcd_barrier_post((unsigned*)(ws + WS_BAR), MISC + 8);
#pragma unroll 1
  for (int ph = a.ph_lo; ph < a.ph_hi; ++ph) {
    if (ph > a.ph_lo) {
      if (ph == a.ph_lo + 1) cg::this_grid().sync();
      else { xcd_barrier(xbar);
#if PROBE == 3
        xcd_barrier(xbar); xcd_barrier(xbar);
#endif
      }
    }
    int tid = threadIdx.x; asm volatile("" : "+v"(tid));
    const int lane = tid & 63, wave = __builtin_amdgcn_readfirstlane(tid >> 6), gw = vcu * 8 + wave;
    int scr = 0;
    enum { K_NONE, K_GEMM, K_EW, K_POOL, K_MOBA, K_XATT, K_PRO };
    int kind = K_NONE;
    GemmDesc g; g.A = nullptr; g.Bt = nullptr; g.lda = DM; g.ldb = DM; g.K = DM; g.nM = M / BM; g.nN = 4; g.mode = GM_NORMAL;
    g.epi = EPI_F16; g.act = 0; g.O = nullptr; g.ldc = DM; g.colscale = nullptr; g.cscale = 1.f; g.rope = ROPE; g.kmean = KMEAN;
    const float* ew_post = nullptr; const float* ew_pre = nullptr; int li = 0; bool conv23 = false;
    if (ph == 0) kind = K_PRO;
    else if (ph == 1) {
      kind = K_GEMM; g.A = BIG; g.Bt = BIG + 8 * MiB; g.nM = 32; g.nN = 8; g.mode = GM_KVM; g.O = KVM; g.ldc = 2048;
    } else {
      li = (ph - 2) / 11; const int s = (ph - 2) % 11; const bool moba = (li & 1) != 0;
      const f16* wl = (const f16*)(ws + WS_W);
      const float* gl = gains + (size_t)li * 6 * DM;
      switch (s) {
        case 0:
          kind = K_GEMM; g.A = R1;
          if (!moba) { g.Bt = wl + WP_IN / 2; g.O = BIG; }
          else { g.Bt = wl + WM_QKV / 2; g.nN = 12; g.O = BIG; g.ldc = 3 * DM; g.epi = EPI_QKV; g.cscale = 0.08838834764831845f * LOG2E; g.kmean = KMEAN + (size_t)(li >> 1) * 65536; }
          break;
        case 1: kind = moba ? K_MOBA : K_POOL; break;
        case 2:
          kind = K_GEMM; g.O = R1;
          if (!moba) { g.A = BIG + 16 * MiB; g.Bt = wl + WP_GRP / 2; g.ldb = 256; g.K = 256; g.mode = GM_GROUPED; g.colscale = a.in[6] + (size_t)(li >> 1) * DM; }
          else { g.A = BIG + 48 * MiB; g.Bt = wl + WM_O / 2; }
          break;
        case 3: kind = K_EW; ew_post = gl + 1 * DM; ew_pre = gl + 2 * DM; break;
        case 4: kind = K_GEMM; g.A = R1; g.Bt = wl + (moba ? WM_XQ : WP_XQ) / 2; g.O = BIG; g.cscale = 0.0625f * LOG2E; break;
        case 5: kind = K_XATT; break;
        case 6: kind = K_GEMM; g.A = BIG + 16 * MiB; g.Bt = wl + (moba ? WM_XO : WP_XO) / 2; g.O = R1; break;
        case 7: kind = K_EW; ew_post = gl + 3 * DM; ew_pre = gl + 4 * DM; break;
        case 8: kind = K_GEMM; g.A = R1; g.Bt = wl + (moba ? WM_W1 : WP_W1) / 2; g.nN = 16; g.O = BIG; g.ldc = DFF; g.act = 1; break;
        case 9: kind = K_GEMM; g.A = BIG; g.lda = DFF; g.Bt = wl + (moba ? WM_W2 : WP_W2) / 2; g.ldb = DFF; g.K = DFF; g.O = R1; break;
        default: kind = K_EW; ew_post = gl + 5 * DM; ew_pre = (li + 1 < DEPTH) ? gl + 6 * DM : nullptr; conv23 = (li == 1); break;
      }
    }

    if (kind == K_GEMM) {
#if PROBE == 1
#pragma unroll 1
      for (int rep = 0; rep < 2; ++rep) { gemm_phase(lds, g, G, bx, tid); __syncthreads(); g.kmean = nullptr; }
#else
      gemm_phase(lds, g, G, bx, tid);
#endif
    } else if (kind == K_EW) {
      ew_phase(vcu, G, wave, lane, nullptr, X, R1, ew_post, ew_pre);
#if PROBE == 4
      if (ew_pre) { __syncthreads(); ew_phase(vcu, G, wave, lane, nullptr, X, R1, nullptr, ew_pre); }
#endif
#if PROBE == 5
      for (int rep = 0; rep < 2; ++rep)
#endif
      if (conv23) { conv_layer(a, 2, scr, gw, NGW, lane); conv_layer(a, 3, scr, gw, NGW, lane); }
    } else if (kind == K_POOL) {
#if PROBE == 6
      for (int rep = 0; rep < 2; ++rep)
#endif
      pool_phase(vcu, G, BIG, BIG + 16 * MiB, tid);
    } else if (kind == K_MOBA) {
      const float* km = KMEAN + (size_t)(li >> 1) * 65536;
#if PROBE == 2
      for (int rep = 0; rep < 2; ++rep)
#endif
      for (int uid = vcu; uid < 512; uid += G) {
        const int bh = (uid & 255) >> 2, qb = (uid < 256) ? (uid & 3) : 7 - (uid & 3), b = bh >> 3, h = bh & 7;
        const f16* base = BIG + (size_t)b * SEQ * 3 * DM + h * 128;
        attn_unit<128, true>(lds, base + (size_t)qb * 256 * 3 * DM, 3 * DM, base + DM, base + 2 * DM, 3 * DM,
                             BIG + 48 * MiB + (size_t)(b * SEQ + qb * 256) * DM + h * 128, DM, qb, km + (size_t)bh * 8 * 128, tid);
      }
    } else if (kind == K_XATT) {
#if PROBE == 2
      for (int rep = 0; rep < 2; ++rep)
#endif
      for (int uid = vcu; uid < 256; uid += G) {
        const int b = uid >> 5, h = (uid >> 3) & 3, qt = uid & 7;
        const f16* kv = KVM + (size_t)li * 2048 * 2048 + (size_t)b * NMEM * 2048 + h * 256;
        attn_unit<256, false>(lds, BIG + (size_t)(b * SEQ + qt * 256) * DM + h * 256, DM, kv, kv + DM, 2048,
                              BIG + 16 * MiB + (size_t)(b * SEQ + qt * 256) * DM + h * 256, DM, 0, nullptr, tid);
      }
    } else if (kind == K_PRO) {
#if PROBE == 5
      for (int rep = 0; rep < 2; ++rep) {
#else
      {
#endif
      conv_layer(a, 0, scr, gw, NGW, lane); conv_layer(a, 1, scr, gw, NGW, lane);
      for (int i = 0; i < DEPTH; ++i) conv_matrix(a.in[10] + (size_t)i * DM * 2 * DM, DM, 2 * DM, BIG + 8 * MiB + (size_t)i * 2048 * DM, DM, scr, gw, NGW, lane);
      }
      for (int r = gw; r < BATCH * NMEM; r += NGW) {
        const float* mr = a.in[1] + (size_t)r * DM + lane * 4; f32x4 v[4]; float ss = 0.f;
#pragma unroll
        for (int j = 0; j < 4; ++j) { v[j] = *(const f32x4*)(mr + 256 * j); ss += v[j][0] * v[j][0] + v[j][1] * v[j][1] + v[j][2] * v[j][2] + v[j][3] * v[j][3]; }
        const float rstd = 1.0f / sqrtf(wave_sum(ss) * (1.0f / DM) + RMS_EPS);
        for (int i = 0; i < DEPTH; ++i) {
          const float* gm = a.in[3] + (size_t)i * DM + lane * 4; f16* orow = BIG + ((size_t)i * 2048 + r) * DM + lane * 4;
#pragma unroll
          for (int j = 0; j < 4; ++j) { const f32x4 gg = *(const f32x4*)(gm + 256 * j); const f32x4 h = v[j] * rstd * gg; u32x2 w; w.x = pk_f16(h[0], h[1]); w.y = pk_f16(h[2], h[3]); *(u32x2*)(orow + 256 * j) = w; }
        }
      }
      for (int id = vcu * 512 + tid; id < SEQ * 16; id += G * 512) {
        const int pos = id >> 4, i = id & 15;
        const double rev = (double)pos * INV_FREQ[i] * 0.15915494309189535;
        const float fr = (float)(rev - (double)(long long)rev);
        ROPE[id] = __builtin_amdgcn_cosf(fr); ROPE[SEQ * 16 + id] = __builtin_amdgcn_sinf(fr);
      }
      for (int id = vcu * 512 + tid; id < 2 * 65536; id += G * 512) KMEAN[id] = 0.f;
      ew_phase(vcu, G, wave, lane, a.in[0], X, R1, nullptr, gains);
    }
    __syncthreads();
  }
}

extern "C" void kernel_launch(void* const* d_in, const int* in_sizes, int n_in, void* d_out, int out_size, void* d_ws, size_t ws_size, hipStream_t stream) {
  static int grid = 0;
  if (grid == 0) {
    int dev = 0, cus = 0, per_cu = 0;
    hipGetDevice(&dev);
    hipDeviceGetAttribute(&cus, hipDeviceAttributeMultiprocessorCount, dev);
    hipFuncSetAttribute((const void*)mega_fwd, hipFuncAttributeMaxDynamicSharedMemorySize, LDS_BYTES);
    hipOccupancyMaxActiveBlocksPerMultiprocessor(&per_cu, (const void*)mega_fwd, 512, LDS_BYTES);
    if (per_cu < 1) { fprintf(stderr, "occupancy query returned %d\n", per_cu); per_cu = 1; }
    (void)hipGetLastError();
    grid = cus;
    if (ws_size < WS_END) fprintf(stderr, "workspace too small: %zu\n", ws_size);
  }
  (void)hipMemsetAsync((char*)d_ws + WS_BAR, 0, XCD_BAR_WORDS * 4, stream);
  Args a{};
  for (int i = 0; i < 14; ++i) a.in[i] = (const float*)d_in[i];
  a.out = (float*)d_out; a.ws = (unsigned char*)d_ws;
#if MULTI_LAUNCH
  for (int ph = 0; ph < NPHASE; ++ph) { a.ph_lo = ph; a.ph_hi = ph + 1; hipLaunchKernelGGL(mega_fwd, dim3(grid), dim3(512), LDS_BYTES, stream, a); }
#else
  a.ph_lo = 0; a.ph_hi = NPHASE;
  void* args[] = {&a};
  hipError_t e = hipLaunchCooperativeKernel((const void*)mega_fwd, dim3(grid), dim3(512), args, LDS_BYTES, stream);
  if (e != hipSuccess) fprintf(stderr, "cooperative launch failed: %s (grid %d)\n", hipGetErrorString(e), grid);
#endif
}
```

```cpp
#include <hip/hip_runtime.h>
#include <hip/hip_cooperative_groups.h>
#include <cstdio>
#include <cstdint>
namespace cg = cooperative_groups;

#ifndef PROBE
#define PROBE 0
#endif
#ifndef TPROBE
#define TPROBE 0
#endif
#ifndef MULTI_LAUNCH
#define MULTI_LAUNCH 0
#endif

#define LAS __attribute__((address_space(3)))
typedef _Float16 f16;
typedef _Float16 h8 __attribute__((ext_vector_type(8)));
typedef _Float16 h4 __attribute__((ext_vector_type(4)));
typedef _Float16 h2 __attribute__((ext_vector_type(2)));
typedef short s16x4 __attribute__((ext_vector_type(4)));
typedef float f32x2 __attribute__((ext_vector_type(2)));
typedef float f32x4 __attribute__((ext_vector_type(4)));
typedef float f32x16 __attribute__((ext_vector_type(16)));
typedef unsigned u32x4 __attribute__((ext_vector_type(4)));
typedef unsigned u32x2 __attribute__((ext_vector_type(2)));

constexpr int DM = 1024, BATCH = 8, SEQ = 2048, DEPTH = 4, NMEM = 256, DFF = 4096;
constexpr int M = BATCH * SEQ;
constexpr float RMS_EPS = 1e-6f;
constexpr float LOG2E = 1.4426950408889634f;

constexpr size_t MiB = 1u << 20;
constexpr size_t WS_KMEAN = 0;
constexpr size_t WS_ROPE = 512 * 1024;
constexpr size_t WS_W = 1 * MiB;
constexpr size_t WS_KVM = 60 * MiB;
constexpr size_t WS_R1 = 92 * MiB;
constexpr size_t WS_BIG = 124 * MiB;
constexpr size_t WS_END = 252 * MiB;
constexpr size_t WP_IN = 0, WP_GRP = 2 * MiB, WP_XQ = 3 * MiB, WP_XO = 5 * MiB, WP_W1 = 7 * MiB, WP_W2 = 15 * MiB;
constexpr size_t WM_QKV = 23 * MiB, WM_O = 29 * MiB, WM_XQ = 31 * MiB, WM_XO = 33 * MiB, WM_W1 = 35 * MiB, WM_W2 = 43 * MiB;

constexpr int LDS_BYTES = 131072 + 64;
constexpr size_t WS_BAR = 800 * 1024;
constexpr size_t WS_XCNT = 816 * 1024;
constexpr size_t WS_XSLOT = 52 * MiB;

__device__ __forceinline__ unsigned pk_f16(float lo, float hi) { f32x2 v = {lo, hi}; h2 h = __builtin_convertvector(v, h2); return __builtin_bit_cast(unsigned, h); }
__device__ __forceinline__ float wave_sum(float v) {
#pragma unroll
  for (int o = 1; o < 64; o <<= 1) v += __shfl_xor(v, o);
  return v;
}

constexpr int BM = 256, BK = 64, HALF = 128, HTB = HALF * BK * 2, NXCD = 8, WGM = 2;
__device__ __forceinline__ int lds_byte(int r, int c) { const int st = (r >> 4) * 2 + (c >> 5), rr = r & 15, cc = c & 31, ob = rr * 64 + cc * 2; return st * 1024 + (ob ^ (((ob >> 9) & 1) << 5)); }
__device__ __forceinline__ void stage_rc(int b, int& R, int& C) { const int st = b / 1024, sb = b % 1024, swz = sb ^ (((sb >> 9) & 1) << 5); R = (st >> 1) * 16 + swz / 64; C = (st & 1) * 32 + (swz % 64) / 2; }
__device__ __forceinline__ int perm32(int rho) { const int n = rho >> 4, i = rho & 15; return 8 * (i >> 2) + 4 * n + (i & 3); }

struct Unit { int pm, pn; };
enum { EPI_F16 = 0, EPI_QKV = 1 };
enum { GM_NORMAL = 0, GM_GROUPED = 1, GM_KVM = 2 };
struct GemmDesc {
  const f16* A; const f16* Bt; int lda, ldb, K, nM, nN, mode;
  int epi, act; f16* O; int ldc; const float* colscale; float cscale;
  const float* rope; float* kmean;
  int fuse; unsigned want; const float* g1; const float* g2; float* X; float* xslot; unsigned* xcnt;
};

__device__ __forceinline__ bool sched_next(const GemmDesc& g, int G, int c, int i, Unit& u) {
  const int nM = g.nM, nN = g.nN, nwg = nM * nN;
  const long L = (long)i * G + c; if (L >= nwg) return false;
  int wgid = (int)L; { const int q = nwg / NXCD, r = nwg % NXCD, xcd = wgid % NXCD, off = wgid / NXCD; wgid = (xcd < r ? xcd * (q + 1) : r * (q + 1) + (xcd - r) * q) + off; }
  const int nig = WGM * nN, gid = wgid / nig, fm = gid * WGM, gsz = (nM - fm) < WGM ? (nM - fm) : WGM;
  u.pm = fm + ((wgid % nig) % gsz); u.pn = (wgid % nig) / gsz; return true;
}

__device__ __forceinline__ void gemm_epilogue(const f32x4 (&acc)[2][2][4][2], const GemmDesc& g, const Unit& u, int wr, int wc, int fr, int fq) {
  const int row0 = u.pm * BM + wr * 64 + fr;
  const int col0 = u.pn * BM + wc * 32 + 8 * fq;
  if (g.epi == EPI_F16) {
    float cs[2][8];
#pragma unroll
    for (int bj = 0; bj < 2; ++bj) {
      if (g.colscale) { const f32x4 a = *(const f32x4*)(g.colscale + col0 + bj * HALF), b = *(const f32x4*)(g.colscale + col0 + bj * HALF + 4);
        cs[bj][0] = a[0] * g.cscale; cs[bj][1] = a[1] * g.cscale; cs[bj][2] = a[2] * g.cscale; cs[bj][3] = a[3] * g.cscale;
        cs[bj][4] = b[0] * g.cscale; cs[bj][5] = b[1] * g.cscale; cs[bj][6] = b[2] * g.cscale; cs[bj][7] = b[3] * g.cscale;
      } else {
#pragma unroll
        for (int e = 0; e < 8; ++e) cs[bj][e] = g.cscale;
      }
    }
    const bool act = g.act != 0;
#pragma unroll
    for (int ai = 0; ai < 2; ++ai)
#pragma unroll
      for (int m = 0; m < 4; ++m) {
        f16* rowp = g.O + (size_t)(row0 + ai * HALF + m * 16) * g.ldc + col0;
#pragma unroll
        for (int bj = 0; bj < 2; ++bj) {
          f32x4 v0 = acc[ai][bj][m][0], v1 = acc[ai][bj][m][1];
          if (act) {
#pragma unroll
            for (int e = 0; e < 4; ++e) { float a = fmaxf(v0[e], 0.f); v0[e] = a * a; float b = fmaxf(v1[e], 0.f); v1[e] = b * b; }
          }
          u32x4 w;
          w.x = pk_f16(v0[0] * cs[bj][0], v0[1] * cs[bj][1]); w.y = pk_f16(v0[2] * cs[bj][2], v0[3] * cs[bj][3]);
          w.z = pk_f16(v1[0] * cs[bj][4], v1[1] * cs[bj][5]); w.w = pk_f16(v1[2] * cs[bj][6], v1[3] * cs[bj][7]);
          *(u32x4*)(rowp + bj * HALF) = w;
        }
      }
  } else {
    const int which = u.pn >> 2;
    const bool dorope = (which < 2) && (wc == 0);
    const float qs = (which == 0) ? g.cscale : 1.f;
    float ksum[2][8];
#pragma unroll
    for (int bj = 0; bj < 2; ++bj)
#pragma unroll
      for (int e = 0; e < 8; ++e) ksum[bj][e] = 0.f;
#pragma unroll
    for (int ai = 0; ai < 2; ++ai)
#pragma unroll
      for (int m = 0; m < 4; ++m) {
        const int row = row0 + ai * HALF + m * 16;
        f16* rowp = g.O + (size_t)row * g.ldc + col0;
        float cv[8], sv[8];
        if (dorope) {
          const float* rp = g.rope + (size_t)(row & (SEQ - 1)) * 16 + 8 * (fq & 1);
          const f32x4 c0 = *(const f32x4*)rp, c1 = *(const f32x4*)(rp + 4), s0 = *(const f32x4*)(rp + SEQ * 16), s1 = *(const f32x4*)(rp + SEQ * 16 + 4);
          const float sg = (fq < 2) ? -1.f : 1.f;
#pragma unroll
          for (int e = 0; e < 4; ++e) { cv[e] = c0[e]; cv[4 + e] = c1[e]; sv[e] = s0[e] * sg; sv[4 + e] = s1[e] * sg; }
        }
#pragma unroll
        for (int bj = 0; bj < 2; ++bj) {
          float v[8];
#pragma unroll
          for (int e = 0; e < 4; ++e) { v[e] = acc[ai][bj][m][0][e]; v[4 + e] = acc[ai][bj][m][1][e]; }
          if (dorope) {
#pragma unroll
            for (int e = 0; e < 8; ++e) { const float p = __shfl_xor(v[e], 32); v[e] = v[e] * cv[e] + p * sv[e]; }
          }
          if (which == 1) {
#pragma unroll
            for (int e = 0; e < 8; ++e) ksum[bj][e] += v[e];
          }
          u32x4 w;
          w.x = pk_f16(v[0] * qs, v[1] * qs); w.y = pk_f16(v[2] * qs, v[3] * qs); w.z = pk_f16(v[4] * qs, v[5] * qs); w.w = pk_f16(v[6] * qs, v[7] * qs);
          *(u32x4*)(rowp + bj * HALF) = w;
        }
      }
    if (which == 1 && g.kmean) {
      const int b = u.pm >> 3, blk = u.pm & 7;
#pragma unroll
      for (int bj = 0; bj < 2; ++bj) {
        const int head = 2 * (u.pn & 3) + bj;
        float* kp = g.kmean + ((size_t)((b * 8 + head) * 8 + blk)) * 128 + wc * 32 + 8 * fq;
#pragma unroll
        for (int e = 0; e < 8; ++e) {
          float s = ksum[bj][e];
          s += __shfl_xor(s, 1); s += __shfl_xor(s, 2); s += __shfl_xor(s, 4); s += __shfl_xor(s, 8);
          if (fr == 0) atomicAdd(kp + e, s);
        }
      }
    }
  }
}


__device__ __forceinline__ void panel_rstd(const f32x4 (&v)[2][2][4][2], const Unit& u, int wr, int wc, int fr, int fq, LAS unsigned char* lds, int wid, int lane,
                                           float* slots, unsigned* cnt, unsigned want) {
  LAS float* P = (LAS float*)lds; LAS float* S = (LAS float*)(lds + 4096);
#pragma unroll
  for (int ai = 0; ai < 2; ++ai)
#pragma unroll
    for (int m = 0; m < 4; ++m) {
      float q = 0.f;
#pragma unroll
      for (int bj = 0; bj < 2; ++bj)
#pragma unroll
        for (int n = 0; n < 2; ++n) { const f32x4 x = v[ai][bj][m][n]; q += (x[0] * x[0] + x[1] * x[1]) + (x[2] * x[2] + x[3] * x[3]); }
      q += __shfl_xor(q, 16); q += __shfl_xor(q, 32);
      if (fq == 0) P[(ai * HALF + wr * 64 + m * 16 + fr) * 4 + wc] = q;
    }
  asm volatile("s_waitcnt lgkmcnt(0)" ::: "memory"); __builtin_amdgcn_s_barrier(); asm volatile("" ::: "memory");
  const int row = wid * 32 + (lane & 31);
  if (lane < 32) {
    const f32x4 p = *(const LAS f32x4*)(P + row * 4);
    const float mine = (p[0] + p[1]) + (p[2] + p[3]);
    unsigned long long* sl = (unsigned long long*)slots + (size_t)(u.pm * BM + row) * 4;
    __hip_atomic_store(sl + u.pn, ((unsigned long long)want << 32) | __float_as_uint(mine), __ATOMIC_RELAXED, __HIP_MEMORY_SCOPE_AGENT);
    float t = 0.f;
#pragma unroll
    for (int k = 0; k < 4; ++k) {
      float val = mine;
      if (k != u.pn) {
        unsigned sp = 0;
        for (;;) {
          const unsigned long long w = __hip_atomic_load(sl + k, __ATOMIC_RELAXED, __HIP_MEMORY_SCOPE_AGENT);
          if ((unsigned)(w >> 32) == want) { val = __uint_as_float((unsigned)w); break; }
          if (++sp > (1u << 22)) break;
          __builtin_amdgcn_s_sleep(1);
        }
      }
      t += val;
    }
    S[row] = 1.0f / sqrtf(t * (1.0f / DM) + RMS_EPS);
  }
  asm volatile("s_waitcnt vmcnt(0) lgkmcnt(0)" ::: "memory"); __builtin_amdgcn_s_barrier(); asm volatile("" ::: "memory");
}
__device__ __forceinline__ void fused_epilogue(f32x4 (&acc)[2][2][4][2], const GemmDesc& g, const Unit& u, int wr, int wc, int fr, int fq, LAS unsigned char* lds, int wid, int lane) {
  const LAS float* S = (const LAS float*)(lds + 4096);
  const int col0 = u.pn * BM + wc * 32 + 8 * fq;
  if (g.colscale) {
#pragma unroll
    for (int bj = 0; bj < 2; ++bj) {
      const f32x4 c0 = *(const f32x4*)(g.colscale + col0 + bj * HALF), c1 = *(const f32x4*)(g.colscale + col0 + bj * HALF + 4);
#pragma unroll
      for (int ai = 0; ai < 2; ++ai)
#pragma unroll
        for (int m = 0; m < 4; ++m) { acc[ai][bj][m][0] = acc[ai][bj][m][0] * c0; acc[ai][bj][m][1] = acc[ai][bj][m][1] * c1; }
    }
  }
  f32x4 xpre[4][2][2];
#pragma unroll
  for (int m = 0; m < 4; ++m) { const float* xp = g.X + (size_t)(u.pm * BM + wr * 64 + m * 16 + fr) * DM + col0;
#pragma unroll
    for (int bj = 0; bj < 2; ++bj) { xpre[m][bj][0] = *(const f32x4*)(xp + bj * HALF); xpre[m][bj][1] = *(const f32x4*)(xp + bj * HALF + 4); } }
  panel_rstd(acc, u, wr, wc, fr, fq, lds, wid, lane, g.xslot, g.xcnt, g.want);
  {
    f32x4 ga[2][2];
#pragma unroll
    for (int bj = 0; bj < 2; ++bj) { ga[bj][0] = *(const f32x4*)(g.g1 + col0 + bj * HALF); ga[bj][1] = *(const f32x4*)(g.g1 + col0 + bj * HALF + 4); }
#pragma unroll
    for (int ai = 0; ai < 2; ++ai)
#pragma unroll
      for (int m = 0; m < 4; ++m) {
        const int r = ai * HALF + wr * 64 + m * 16 + fr; const float sr = S[r];
        const float* xp = g.X + (size_t)(u.pm * BM + r) * DM + col0;
#pragma unroll
        for (int bj = 0; bj < 2; ++bj) {
          const f32x4 x0 = ai == 0 ? xpre[m][bj][0] : *(const f32x4*)(xp + bj * HALF), x1 = ai == 0 ? xpre[m][bj][1] : *(const f32x4*)(xp + bj * HALF + 4);
          acc[ai][bj][m][0] = x0 + acc[ai][bj][m][0] * sr * ga[bj][0]; acc[ai][bj][m][1] = x1 + acc[ai][bj][m][1] * sr * ga[bj][1];
        }
      }
  }
  if (g.g2) {
    panel_rstd(acc, u, wr, wc, fr, fq, lds, wid, lane, g.xslot + (size_t)M * 8, g.xcnt + 64 * 64, g.want);
    f32x4 gb[2][2];
#pragma unroll
    for (int bj = 0; bj < 2; ++bj) { gb[bj][0] = *(const f32x4*)(g.g2 + col0 + bj * HALF); gb[bj][1] = *(const f32x4*)(g.g2 + col0 + bj * HALF + 4); }
#pragma unroll
    for (int ai = 0; ai < 2; ++ai)
#pragma unroll
      for (int m = 0; m < 4; ++m) {
        const int r = ai * HALF + wr * 64 + m * 16 + fr; const float sr = S[r];
        float* xp = g.X + (size_t)(u.pm * BM + r) * DM + col0;
        f16* hp = g.O + (size_t)(u.pm * BM + r) * DM + col0;
#pragma unroll
        for (int bj = 0; bj < 2; ++bj) {
          const f32x4 a0 = acc[ai][bj][m][0], a1 = acc[ai][bj][m][1];
          *(f32x4*)(xp + bj * HALF) = a0; *(f32x4*)(xp + bj * HALF + 4) = a1;
          const f32x4 h0 = a0 * sr * gb[bj][0], h1 = a1 * sr * gb[bj][1];
          u32x4 w; w.x = pk_f16(h0[0], h0[1]); w.y = pk_f16(h0[2], h0[3]); w.z = pk_f16(h1[0], h1[1]); w.w = pk_f16(h1[2], h1[3]);
          *(u32x4*)(hp + bj * HALF) = w;
        }
      }
  } else {
#pragma unroll
    for (int ai = 0; ai < 2; ++ai)
#pragma unroll
      for (int m = 0; m < 4; ++m) {
        const int r = ai * HALF + wr * 64 + m * 16 + fr;
        float* xp = g.X + (size_t)(u.pm * BM + r) * DM + col0;
#pragma unroll
        for (int bj = 0; bj < 2; ++bj) { *(f32x4*)(xp + bj * HALF) = acc[ai][bj][m][0]; *(f32x4*)(xp + bj * HALF + 4) = acc[ai][bj][m][1]; }
      }
  }
}

__device__ __forceinline__ void gemm_phase(LAS unsigned char* lds, const GemmDesc& g, int G, int c, const int tid) {
  const int wid = __builtin_amdgcn_readfirstlane(tid >> 6), lane = tid & 63, wr = wid >> 2, wc = wid & 3, fr = lane & 15, fq = lane >> 4;
  const int K = g.K, nt = K / BK;
  unsigned voffA[2], voffB[2];
#pragma unroll
  for (int i = 0; i < 2; ++i) { int R, C; stage_rc(tid * 16 + i * 8192, R, C); const int Rb = (R & ~31) + perm32(R & 31);
    voffA[i] = (unsigned)(R * g.lda + C) * 2u; voffB[i] = (unsigned)(Rb * g.ldb + C) * 2u; }
  const size_t kstep = (size_t)(BK * 2);
  const size_t hstepA = (size_t)HALF * g.lda * 2, hstepB = (size_t)HALF * g.ldb * 2;
  const size_t tstepA = 2 * hstepA, tstepB = 2 * hstepB;
  const unsigned ldsw = (unsigned)wid * 1024u;
  const int aoff = lds_byte(wr * 64 + fr, fq * 8), boff = lds_byte(wc * 32 + fr, fq * 8);
#define UA(u) ((size_t)(u).pm * tstepA + (g.mode == GM_GROUPED ? (size_t)(u).pn * 512 : 0))
#define UB(u) ((size_t)(g.mode == GM_KVM ? (((u).pm >> 3) * 8 + (u).pn) : (u).pn) * tstepB)
#define PG8_SA(b, h) (((b) * 2 + (h)) * HTB)
#define PG8_SB(b, h) ((4 + (b) * 2 + (h)) * HTB)
#define PG8_STAGE(bufoff, gbase, voff) do { _Pragma("unroll") for (int _i = 0; _i < 2; ++_i) \
    __builtin_amdgcn_global_load_lds((const unsigned*)((const char*)(gbase) + (voff)[_i]), (LAS unsigned*)(lds + (bufoff) + ldsw + _i * 8192), 16, 0, 0); } while (0)
#define PG8_LDA(dst, b, h) do { _Pragma("unroll") for (int m = 0; m < 4; ++m) _Pragma("unroll") for (int k = 0; k < 2; ++k) dst[m][k] = *(const LAS h8*)(lds + PG8_SA(b, h) + aoff + m * 2048 + k * 1024); } while (0)
#define PG8_LDB(dst, b, h) do { _Pragma("unroll") for (int n = 0; n < 2; ++n) _Pragma("unroll") for (int k = 0; k < 2; ++k) dst[n][k] = *(const LAS h8*)(lds + PG8_SB(b, h) + boff + n * 2048 + k * 1024); } while (0)
#define PG8_MMA(ai, bj, At, Bt) do { __builtin_amdgcn_s_setprio(1); _Pragma("unroll") for (int m = 0; m < 4; ++m) _Pragma("unroll") for (int n = 0; n < 2; ++n) _Pragma("unroll") for (int k = 0; k < 2; ++k) \
    acc[ai][bj][m][n] = __builtin_amdgcn_mfma_f32_16x16x32_f16(Bt[n][k], At[m][k], acc[ai][bj][m][n], 0, 0, 0); __builtin_amdgcn_s_setprio(0); } while (0)
#define PG8_WAIT_V(n) asm volatile("s_waitcnt vmcnt(" #n ")" ::: "memory")
#define PG8_WAIT_L(n) asm volatile("s_waitcnt lgkmcnt(" #n ")" ::: "memory")
#define PG8_BAR __builtin_amdgcn_s_barrier()
#define PG8_SCHED __builtin_amdgcn_sched_barrier(0)
  Unit cur, nxt; int ui = 0;
  if (!sched_next(g, G, c, 0, cur)) return;
  f32x4 acc[2][2][4][2];
#pragma unroll
  for (int a = 0; a < 2; ++a)
#pragma unroll
    for (int b = 0; b < 2; ++b)
#pragma unroll
      for (int m = 0; m < 4; ++m)
#pragma unroll
        for (int n = 0; n < 2; ++n) acc[a][b][m][n] = (f32x4){0.f, 0.f, 0.f, 0.f};
  h8 At[4][2], B0[2][2], B1[2][2];
  const char* cA = (const char*)g.A + UA(cur); const char* cB = (const char*)g.Bt + UB(cur);
  PG8_STAGE(PG8_SB(0, 0), cB, voffB); PG8_STAGE(PG8_SB(0, 1), cB + hstepB, voffB); PG8_STAGE(PG8_SA(0, 0), cA, voffA); PG8_STAGE(PG8_SA(0, 1), cA + hstepA, voffA);
  if (wr == 1) PG8_BAR;
  PG8_WAIT_V(2); PG8_BAR;
  PG8_STAGE(PG8_SB(1, 0), cB + kstep, voffB); PG8_STAGE(PG8_SA(1, 0), cA + kstep, voffA); PG8_STAGE(PG8_SB(1, 1), cB + hstepB + kstep, voffB);
  PG8_WAIT_V(6); PG8_BAR;
  for (;;) {
    const bool has_next = sched_next(g, G, c, ui + 1, nxt);
    const char* nA = has_next ? (const char*)g.A + UA(nxt) : cA; const char* nB = has_next ? (const char*)g.Bt + UB(nxt) : cB;
    for (int t = 0; t < nt; t += 2) {
      const bool last = (t == nt - 2);
      const char* a1 = cA + (size_t)(t + 1) * kstep;
      const char* a2 = last ? nA : cA + (size_t)(t + 2) * kstep; const char* b2 = last ? nB : cB + (size_t)(t + 2) * kstep;
      const char* a3 = a2 + kstep; const char* b3 = b2 + kstep;
      PG8_LDB(B0, 0, 0); PG8_LDB(B1, 0, 1); PG8_SCHED; PG8_LDA(At, 0, 0); PG8_STAGE(PG8_SA(1, 1), a1 + hstepA, voffA);
      PG8_WAIT_V(8); PG8_WAIT_L(0); PG8_BAR; PG8_MMA(0, 0, At, B0); PG8_MMA(0, 1, At, B1); PG8_BAR; PG8_SCHED;
      PG8_LDA(At, 0, 1); PG8_STAGE(PG8_SB(0, 0), b2, voffB); PG8_STAGE(PG8_SB(0, 1), b2 + hstepB, voffB); PG8_STAGE(PG8_SA(0, 0), a2, voffA);
      PG8_WAIT_V(8); PG8_WAIT_L(0); PG8_BAR; PG8_MMA(1, 0, At, B0); PG8_MMA(1, 1, At, B1); PG8_BAR; PG8_SCHED;
      PG8_LDB(B0, 1, 0); PG8_LDB(B1, 1, 1); PG8_SCHED; PG8_LDA(At, 1, 0); PG8_STAGE(PG8_SA(0, 1), a2 + hstepA, voffA);
      PG8_WAIT_V(8); PG8_WAIT_L(0); PG8_BAR; PG8_MMA(0, 0, At, B0); PG8_MMA(0, 1, At, B1); PG8_BAR; PG8_SCHED;
      PG8_LDA(At, 1, 1); PG8_STAGE(PG8_SB(1, 0), b3, voffB); PG8_STAGE(PG8_SB(1, 1), b3 + hstepB, voffB); PG8_STAGE(PG8_SA(1, 0), a3, voffA);
      PG8_WAIT_V(8); PG8_WAIT_L(0); PG8_BAR; PG8_MMA(1, 0, At, B0); PG8_MMA(1, 1, At, B1); PG8_BAR; PG8_SCHED;
    }
    if (wr == 0) PG8_BAR;
    if (!g.fuse) { int t2 = threadIdx.x; asm volatile("" : "+v"(t2)); gemm_epilogue(acc, g, cur, wr, wc, t2 & 15, (t2 & 63) >> 4); }
    if (!has_next) break;
#pragma unroll
    for (int a = 0; a < 2; ++a)
#pragma unroll
      for (int b = 0; b < 2; ++b)
#pragma unroll
        for (int m = 0; m < 4; ++m)
#pragma unroll
          for (int n = 0; n < 2; ++n) acc[a][b][m][n] = (f32x4){0.f, 0.f, 0.f, 0.f};
    cur = nxt; cA = nA; cB = nB; ++ui;
    if (wr == 1) PG8_BAR;
  }
  PG8_WAIT_V(0);
  PG8_BAR;
  if (g.fuse) { int t2 = threadIdx.x; asm volatile("" : "+v"(t2)); fused_epilogue(acc, g, cur, wr, wc, t2 & 15, (t2 & 63) >> 4, lds, wid, t2 & 63); }
#undef UA
#undef UB
#undef PG8_SA
#undef PG8_SB
#undef PG8_STAGE
#undef PG8_LDA
#undef PG8_LDB
#undef PG8_MMA
#undef PG8_WAIT_V
#undef PG8_WAIT_L
#undef PG8_BAR
#undef PG8_SCHED
}

__device__ __forceinline__ s16x4 vtr(const LAS unsigned char* p) { return __builtin_amdgcn_ds_read_tr16_b64_v4i16((LAS s16x4*)p); }

template <int HD, bool MOBA>
__device__ __forceinline__ void attn_unit(LAS unsigned char* lds, const f16* Qg, int ldq, const f16* Kg, const f16* Vg, int ldkv,
                                          f16* Og, int ldo, int qb, const float* kmg, const int tid) {
  constexpr int KS = HD * 2 + 16, VS = 320, KT_BYTES = 64 * KS, VT_BYTES = 64 * VS;
  constexpr int NSTEP = HD / 16, NPASS = HD / 128, KCH = HD / 8, KPT = 64 * KCH / 512, VPT = 2;
  constexpr int BUFB = KT_BYTES + VT_BYTES;
  LAS unsigned char* Kl = lds; LAS unsigned char* Vl = lds + KT_BYTES; LAS float* kml = (LAS float*)(lds + 2 * BUFB);
  const int lane = tid & 63, wid = __builtin_amdgcn_readfirstlane(tid >> 6), r32 = lane & 31, hi = lane >> 5;
  const float NEG = -INFINITY;
  constexpr bool QREG = true;
  constexpr int NQF = QREG ? NSTEP : 1;
  h8 qf[NQF];
  const f16* qrow = Qg + (size_t)(wid * 32 + r32) * ldq + hi * 8;
  if (QREG) {
#pragma unroll
    for (int s = 0; s < NQF; ++s) qf[s] = *(const h8*)(qrow + s * 16); }
  unsigned selmask = 0;
  if (MOBA && qb <= 3) selmask = (1u << qb) - 1u;
  if (MOBA && qb > 3) {
    for (int idx = tid; idx < qb * 128; idx += 512) kml[idx] = kmg[idx];
    __syncthreads();
    float gate[7];
#pragma unroll
    for (int j = 0; j < 7; ++j) {
      gate[j] = NEG;
      if (j < qb) {
        float a = 0.f;
#pragma unroll
        for (int s = 0; s < NSTEP; ++s) {
          const f32x4 k0 = *(const LAS f32x4*)(kml + j * 128 + s * 16 + hi * 8), k1 = *(const LAS f32x4*)(kml + j * 128 + s * 16 + hi * 8 + 4);
          a += (float)qf[s][0] * k0[0] + (float)qf[s][1] * k0[1] + (float)qf[s][2] * k0[2] + (float)qf[s][3] * k0[3]
             + (float)qf[s][4] * k1[0] + (float)qf[s][5] * k1[1] + (float)qf[s][6] * k1[2] + (float)qf[s][7] * k1[3];
        }
        a += __shfl_xor(a, 32);
        gate[j] = a;
      }
    }
    {
#pragma unroll
      for (int rnd = 0; rnd < 3; ++rnd) {
        float best = NEG; int bi = 0;
#pragma unroll
        for (int j = 0; j < 7; ++j) { const bool ok = (j < qb) && !((selmask >> j) & 1u) && (gate[j] > best); if (ok) { best = gate[j]; bi = j; } }
        selmask |= 1u << bi;
      }
    }
  }
  const int NT = MOBA ? 4 * (qb + 1) : 4;
  const LAS unsigned char* kb0 = Kl + r32 * KS + hi * 16;
  const LAS unsigned char* vb0 = Vl + (((lane & 15) >> 2) + 4 * hi) * VS + (16 * ((lane >> 4) & 1) + 4 * (lane & 3)) * 2;
#pragma unroll 1
  for (int pass = 0; pass < NPASS; ++pass) {
    f32x16 o[4];
#pragma unroll
    for (int d = 0; d < 4; ++d)
#pragma unroll
      for (int r = 0; r < 16; ++r) o[d][r] = 0.f;
    float m_run = NEG, l_run = 0.f;
    u32x4 kreg[KPT], vreg[VPT];
#define ATT_KEY0(t) (MOBA ? (((t) < 4 ? qb : (((t) - 4) >> 2)) * 256 + ((t) & 3) * 64) : (t) * 64)
#define ATT_LOAD(t) do { const int key0_ = ATT_KEY0(t); int tid_ = tid; asm volatile("" : "+v"(tid_)); \
      _Pragma("unroll") for (int i = 0; i < KPT; ++i) { const int id = tid_ + 512 * i, row = id / KCH, ch = id % KCH; kreg[i] = *(const u32x4*)(Kg + (size_t)(key0_ + row) * ldkv + ch * 8); } \
      _Pragma("unroll") for (int i = 0; i < VPT; ++i) { const int id = tid_ + 512 * i, row = id >> 4, ch = id & 15; vreg[i] = *(const u32x4*)(Vg + pass * 128 + (size_t)(key0_ + row) * ldkv + ch * 8); } } while (0)
#define ATT_STORE(bo) do { \
      _Pragma("unroll") for (int i = 0; i < KPT; ++i) { const int id = tid + 512 * i, row = id / KCH, ch = id % KCH; *(LAS u32x4*)(Kl + (bo) + row * KS + ch * 16) = kreg[i]; } \
      _Pragma("unroll") for (int i = 0; i < VPT; ++i) { const int id = tid + 512 * i, row = id >> 4, ch = id & 15; *(LAS u32x4*)(Vl + (bo) + row * VS + ch * 16) = vreg[i]; } } while (0)
    ATT_LOAD(0);
    ATT_STORE(0);
    if (NT > 1) ATT_LOAD(1);
    __syncthreads();
#define ATT_TILE(OWN_) do { \
      const int bo = (t & 1) * BUFB; \
      const LAS unsigned char* kb = kb0 + bo; const LAS unsigned char* vb = vb0 + bo; \
      const int blk = MOBA ? (OWN_ ? qb : ((t - 4) >> 2)) : 0, kt = t & 3; \
      const bool own = MOBA && OWN_; \
      const bool sel = own || !MOBA || (((selmask >> blk) & 1u) != 0u); \
      bool need = true; \
      if (MOBA) { if (own) need = (kt <= (wid >> 1)); else need = (__ballot((selmask >> blk) & 1u) != 0ull); } \
      if (need) { \
        f32x16 p0, p1; \
        const f32x16 zero16 = {0.f, 0.f, 0.f, 0.f, 0.f, 0.f, 0.f, 0.f, 0.f, 0.f, 0.f, 0.f, 0.f, 0.f, 0.f, 0.f}; \
        const f16* qr = qrow; if (!QREG) asm volatile("" : "+v"(qr)); \
      _Pragma("unroll") \
        for (int s = 0; s < NSTEP; ++s) { \
          const h8 k0 = *(const LAS h8*)(kb + s * 32), k1 = *(const LAS h8*)(kb + 32 * KS + s * 32); \
          const h8 q = QREG ? qf[QREG ? s : 0] : *(const h8*)(qr + s * 16); \
          p0 = __builtin_amdgcn_mfma_f32_32x32x16_f16(k0, q, s == 0 ? zero16 : p0, 0, 0, 0); \
          p1 = __builtin_amdgcn_mfma_f32_32x32x16_f16(k1, q, s == 0 ? zero16 : p1, 0, 0, 0); \
        } \
        if (MOBA && own) { \
          const int qpos = wid * 32 + r32, kbase = kt * 64 + 4 * hi; \
      _Pragma("unroll") \
          for (int r = 0; r < 16; ++r) { const int kv = kbase + (r & 3) + 8 * (r >> 2); if (kv > qpos) p0[r] = NEG; if (kv + 32 > qpos) p1[r] = NEG; } \
        } \
        float mx = fmaxf(p0[0], p1[0]); \
      _Pragma("unroll") \
        for (int r = 1; r < 16; ++r) mx = fmaxf(mx, fmaxf(p0[r], p1[r])); \
        mx = fmaxf(mx, __shfl_xor(mx, 32)); \
        if (!sel) mx = NEG; \
        const float m_new = fmaxf(m_run, mx); \
        const float alpha = __builtin_amdgcn_exp2f(m_run - m_new); \
        m_run = m_new; \
        float ps = 0.f; \
        const float m_sub = sel ? m_new : INFINITY; \
      _Pragma("unroll") \
        for (int r = 0; r < 16; ++r) { p0[r] = __builtin_amdgcn_exp2f(p0[r] - m_sub); p1[r] = __builtin_amdgcn_exp2f(p1[r] - m_sub); ps += p0[r] + p1[r]; } \
        l_run = l_run * alpha + ps; \
        if (__ballot(alpha != 1.0f) != 0ull) { \
      _Pragma("unroll") \
          for (int d = 0; d < 4; ++d) \
      _Pragma("unroll") \
            for (int r = 0; r < 16; ++r) o[d][r] *= alpha; \
        } \
        h8 pf[4]; \
        { u32x4 w; \
          w.x = pk_f16(p0[0], p0[1]); w.y = pk_f16(p0[2], p0[3]); w.z = pk_f16(p0[4], p0[5]); w.w = pk_f16(p0[6], p0[7]); pf[0] = __builtin_bit_cast(h8, w); \
          w.x = pk_f16(p0[8], p0[9]); w.y = pk_f16(p0[10], p0[11]); w.z = pk_f16(p0[12], p0[13]); w.w = pk_f16(p0[14], p0[15]); pf[1] = __builtin_bit_cast(h8, w); \
          w.x = pk_f16(p1[0], p1[1]); w.y = pk_f16(p1[2], p1[3]); w.z = pk_f16(p1[4], p1[5]); w.w = pk_f16(p1[6], p1[7]); pf[2] = __builtin_bit_cast(h8, w); \
          w.x = pk_f16(p1[8], p1[9]); w.y = pk_f16(p1[10], p1[11]); w.z = pk_f16(p1[12], p1[13]); w.w = pk_f16(p1[14], p1[15]); pf[3] = __builtin_bit_cast(h8, w); } \
      _Pragma("unroll") \
        for (int s = 0; s < 4; ++s) \
      _Pragma("unroll") \
          for (int d = 0; d < 4; ++d) { \
            const s16x4 lo = vtr(vb + (16 * s) * VS + d * 64), hh = vtr(vb + (16 * s + 8) * VS + d * 64); \
            typedef short s16x8 __attribute__((ext_vector_type(8))); \
            const s16x8 av = {lo[0], lo[1], lo[2], lo[3], hh[0], hh[1], hh[2], hh[3]}; \
            o[d] = __builtin_amdgcn_mfma_f32_32x32x16_f16(__builtin_bit_cast(h8, av), pf[s], o[d], 0, 0, 0); \
          } \
      } \
      if (t + 1 < NT) { ATT_STORE(BUFB - bo); if (t + 2 < NT) ATT_LOAD(t + 2); } \
      __syncthreads(); \
    } while (0)
    int t = 0;
#pragma unroll 1
    for (; t < NT && t < (MOBA ? 4 : NT); ++t) ATT_TILE(1);
#pragma unroll 1
    for (; t < NT; ++t) ATT_TILE(0);
#undef ATT_TILE
#undef ATT_LOAD
#undef ATT_STORE
#undef ATT_KEY0
    const float l = l_run + __shfl_xor(l_run, 32);
    const float inv = 1.0f / l;
    { LAS unsigned char* stg = lds + wid * 8192;
      int l1 = lane; asm volatile("" : "+v"(l1) :: "memory"); const int r1 = l1 & 31, h1 = l1 >> 5;
#pragma unroll
      for (int d = 0; d < 4; ++d)
#pragma unroll
        for (int rg = 0; rg < 4; ++rg) {
          u32x2 w; w.x = pk_f16(o[d][4 * rg] * inv, o[d][4 * rg + 1] * inv); w.y = pk_f16(o[d][4 * rg + 2] * inv, o[d][4 * rg + 3] * inv);
          *(LAS u32x2*)(stg + r1 * 256 + (((4 * d + rg) ^ (r1 & 15)) << 4) + h1 * 8) = w;
        }
      int l2 = lane; asm volatile("" : "+v"(l2) :: "memory");
      const int c2 = l2 & 15, h2 = l2 >> 4;
      f16* obase = Og + (size_t)(wid * 32) * ldo + pass * 128 + c2 * 8;
#pragma unroll
      for (int i = 0; i < 8; ++i) {
        const int q = 4 * i + h2;
        const u32x4 v = *(const LAS u32x4*)(stg + q * 256 + ((c2 ^ (q & 15)) << 4));
        *(u32x4*)(obase + (size_t)q * ldo) = v;
      }
    }
    __syncthreads();
  }
}


__device__ __forceinline__ void xatt_unit(LAS unsigned char* lds, const f16* Qg, const f16* Kg, const f16* Vg, f16* Og, const int tid) {
  constexpr int KS = 528, VS = 576, TB = 64 * VS, LDKV = 2048;
  const int lane = tid & 63, wid = __builtin_amdgcn_readfirstlane(tid >> 6), r32 = lane & 31, hi = lane >> 5;
  h8 qf[16];
  { const f16* qrow = Qg + (size_t)(wid * 32 + r32) * DM + hi * 8;
#pragma unroll
    for (int s = 0; s < 16; ++s) qf[s] = *(const h8*)(qrow + s * 16); }
  u32x4 kreg[4];
#define XLOAD(t) do { int tid_ = tid; asm volatile("" : "+v"(tid_)); const f16* base_ = ((t) < 4) ? Kg + (size_t)((t) * 64) * LDKV : Vg + (size_t)(((t) - 4) * 64) * LDKV; \
    _Pragma("unroll") for (int i = 0; i < 4; ++i) { const int id = tid_ + 512 * i, row = id >> 5, ch = id & 31; kreg[i] = *(const u32x4*)(base_ + (size_t)row * LDKV + ch * 8); } } while (0)
#define XSTORE(t, bo) do { int tid_ = tid; asm volatile("" : "+v"(tid_)); const int st_ = ((t) < 4) ? KS : VS; \
    _Pragma("unroll") for (int i = 0; i < 4; ++i) { const int id = tid_ + 512 * i, row = id >> 5, ch = id & 31; *(LAS u32x4*)(lds + (bo) + row * st_ + ch * 16) = kreg[i]; } } while (0)
  XLOAD(0); XSTORE(0, 0); XLOAD(1);
  __syncthreads();
  f32x16 p[8];
#pragma unroll
  for (int j = 0; j < 8; ++j)
#pragma unroll
    for (int r = 0; r < 16; ++r) p[j][r] = 0.f;
#pragma unroll
  for (int t = 0; t < 4; ++t) {
    const int bo = (t & 1) * TB;
    const LAS unsigned char* kb = lds + bo + r32 * KS + hi * 16;
#pragma unroll
    for (int s = 0; s < 16; ++s) {
      const h8 k0 = *(const LAS h8*)(kb + s * 32), k1 = *(const LAS h8*)(kb + 32 * KS + s * 32);
      p[2 * t] = __builtin_amdgcn_mfma_f32_32x32x16_f16(k0, qf[s], p[2 * t], 0, 0, 0);
      p[2 * t + 1] = __builtin_amdgcn_mfma_f32_32x32x16_f16(k1, qf[s], p[2 * t + 1], 0, 0, 0);
    }
    XSTORE(t + 1, TB - bo); XLOAD(t + 2);
    __syncthreads();
  }
  float mx = p[0][0];
#pragma unroll
  for (int j = 0; j < 8; ++j)
#pragma unroll
    for (int r = 0; r < 16; ++r) mx = fmaxf(mx, p[j][r]);
  mx = fmaxf(mx, __shfl_xor(mx, 32));
  float l = 0.f;
  h8 pf[16];
#pragma unroll
  for (int j = 0; j < 8; ++j) {
#pragma unroll
    for (int r = 0; r < 16; ++r) { p[j][r] = __builtin_amdgcn_exp2f(p[j][r] - mx); l += p[j][r]; }
    u32x4 w;
    w.x = pk_f16(p[j][0], p[j][1]); w.y = pk_f16(p[j][2], p[j][3]); w.z = pk_f16(p[j][4], p[j][5]); w.w = pk_f16(p[j][6], p[j][7]); pf[2 * j] = __builtin_bit_cast(h8, w);
    w.x = pk_f16(p[j][8], p[j][9]); w.y = pk_f16(p[j][10], p[j][11]); w.z = pk_f16(p[j][12], p[j][13]); w.w = pk_f16(p[j][14], p[j][15]); pf[2 * j + 1] = __builtin_bit_cast(h8, w);
  }
  l += __shfl_xor(l, 32);
  const float inv = 1.0f / l;
  f32x16 o[8];
#pragma unroll
  for (int d = 0; d < 8; ++d)
#pragma unroll
    for (int r = 0; r < 16; ++r) o[d][r] = 0.f;
#pragma unroll
  for (int t = 4; t < 8; ++t) {
    const int bo = (t & 1) * TB;
    const LAS unsigned char* vb = lds + bo + (((lane & 15) >> 2) + 4 * hi) * VS + (16 * ((lane >> 4) & 1) + 4 * (lane & 3)) * 2;
#pragma unroll
    for (int s = 0; s < 4; ++s)
#pragma unroll
      for (int d = 0; d < 8; ++d) {
        const s16x4 lo = vtr(vb + (16 * s) * VS + d * 64), hh = vtr(vb + (16 * s + 8) * VS + d * 64);
        typedef short s16x8 __attribute__((ext_vector_type(8)));
        const s16x8 av = {lo[0], lo[1], lo[2], lo[3], hh[0], hh[1], hh[2], hh[3]};
        o[d] = __builtin_amdgcn_mfma_f32_32x32x16_f16(__builtin_bit_cast(h8, av), pf[4 * (t - 4) + s], o[d], 0, 0, 0);
      }
    if (t + 1 < 8) XSTORE(t + 1, TB - bo);
    if (t + 2 < 8) XLOAD(t + 2);
    __syncthreads();
  }
#undef XLOAD
#undef XSTORE
  { LAS unsigned char* stg = lds + wid * 16384; int l1 = lane; asm volatile("" : "+v"(l1) :: "memory"); const int r1 = l1 & 31, h1 = l1 >> 5;
#pragma unroll
    for (int d = 0; d < 8; ++d) {
      asm volatile("" ::: "memory");
#pragma unroll
      for (int rg = 0; rg < 4; ++rg) {
        u32x2 w; w.x = pk_f16(o[d][4 * rg] * inv, o[d][4 * rg + 1] * inv); w.y = pk_f16(o[d][4 * rg + 2] * inv, o[d][4 * rg + 3] * inv);
        *(LAS u32x2*)(stg + r1 * 512 + (((4 * d + rg) ^ r1) << 4) + h1 * 8) = w;
      }
    }
    int l2 = lane; asm volatile("" : "+v"(l2) :: "memory");
    const int c2 = l2 & 31, h2 = l2 >> 5;
    f16* obase = Og + (size_t)(wid * 32) * DM + c2 * 8;
#pragma unroll
    for (int i = 0; i < 16; ++i) {
      const int q = 2 * i + h2;
      const u32x4 v = *(const LAS u32x4*)(stg + q * 512 + ((c2 ^ q) << 4));
      *(u32x4*)(obase + (size_t)q * DM) = v;
    }
  }
  __syncthreads();
}

#define XB_TMO      128
#define XB_XCNT(j)  (256  + 64 * (j))
#define XB_XSUB(j)  (1280 + 64 * (j))
#define XB_XGEN(j)  (2304 + 64 * (j))
#define XB_TOP      3328
#define XB_TOPGEN   3392
#define XCD_BAR_WORDS 3456
#define XB_SPIN_CAP (1u << 22)
__device__ __forceinline__ unsigned xb_ld(unsigned* p)              { return __hip_atomic_load(p, __ATOMIC_RELAXED, __HIP_MEMORY_SCOPE_AGENT); }
__device__ __forceinline__ unsigned xb_add(unsigned* p, unsigned v) { return __hip_atomic_fetch_add(p, v, __ATOMIC_RELAXED, __HIP_MEMORY_SCOPE_AGENT); }
__device__ __forceinline__ unsigned xb_xcc_id() { return (unsigned)__builtin_amdgcn_s_getreg((3 << 11) | 20) & 0xFu; }
#define XB_SPIN(cond, bar) do { unsigned _sp = 0; while (cond) { __builtin_amdgcn_s_sleep(1); \
    if ((++_sp & 255u) == 0u) { if (xb_ld(&(bar)[XB_TMO])) break; if (_sp > XB_SPIN_CAP) { atomicAdd(&(bar)[XB_TMO], 1u); break; } } } } while (0)
struct XcdBarrier { unsigned* bar; unsigned x; volatile LAS unsigned* st; };
__device__ __forceinline__ XcdBarrier xcd_barrier_post(unsigned* bar, volatile LAS unsigned* st) {
  XcdBarrier b; b.bar = bar; b.x = xb_xcc_id(); b.st = st;
  if (threadIdx.x == 0) (void)xb_add(&bar[XB_XCNT(b.x)], 1u);
  return b;
}
__device__ __forceinline__ void xcd_barrier_complete(unsigned* bar, unsigned x, unsigned& nloc, unsigned& nx) {
  const unsigned G = gridDim.x * gridDim.y * gridDim.z;
  unsigned sum, cnt, mine, sp = 0u;
  for (;;) {
    sum = 0u; cnt = 0u; mine = 0u;
#pragma unroll
    for (unsigned j = 0; j < 16; ++j) { const unsigned c = xb_ld(&bar[XB_XCNT(j)]); sum += c; cnt += (c > 0u) ? 1u : 0u; }
    mine = xb_ld(&bar[XB_XCNT(x)]);
    if (sum == G) break;
    __builtin_amdgcn_s_sleep(1);
    if ((++sp & 255u) == 0u) { if (xb_ld(&bar[XB_TMO])) break; if (sp > XB_SPIN_CAP) { atomicAdd(&bar[XB_TMO], 1u); break; } }
  }
  nloc = mine > 0u ? mine : 1u; nx = cnt > 0u ? cnt : 1u;
}
__device__ __forceinline__ void xcd_barrier(const XcdBarrier& b) {
  asm volatile("s_waitcnt vmcnt(0)" ::: "memory");
  __syncthreads();
  if (threadIdx.x == 0) {
    unsigned* bar = b.bar;
    unsigned nloc = b.st[0], nx = b.st[1];
    if (nloc == 0u) { xcd_barrier_complete(bar, b.x, nloc, nx); b.st[0] = nloc; b.st[1] = nx; }
    const unsigned k = b.st[2]; b.st[2] = k + 1u;
    const unsigned old = xb_add(&bar[XB_XSUB(b.x)], 1u);
    if (old + 1u == (k + 1u) * nloc) {
      __builtin_amdgcn_fence(__ATOMIC_RELEASE, "agent");
      asm volatile("s_waitcnt vmcnt(0)" ::: "memory");
      (void)xb_add(&bar[XB_TOP], 1u);
    }
    const unsigned target = (k + 1u) * nx;
    XB_SPIN(xb_ld(&bar[XB_TOP]) < target, bar);
    __builtin_amdgcn_fence(__ATOMIC_ACQUIRE, "agent");
    asm volatile("s_waitcnt vmcnt(0)" ::: "memory");
  }
  __syncthreads();
}

__device__ __forceinline__ void ew_phase(int vcu, int G, int wave, int lane, const float* xin, float* X, f16* R1, const float* gpost, const float* gpre) {
  f32x4 gp[4], gq[4];
#pragma unroll
  for (int j = 0; j < 4; ++j) { gp[j] = gpost ? *(const f32x4*)(gpost + lane * 4 + 256 * j) : (f32x4){0.f, 0.f, 0.f, 0.f}; gq[j] = gpre ? *(const f32x4*)(gpre + lane * 4 + 256 * j) : (f32x4){0.f, 0.f, 0.f, 0.f}; }
#pragma unroll 1
  for (int m = vcu * 8 + wave; m < M; m += G * 8) {
    const float* xr = (xin ? xin : X) + (size_t)m * DM + lane * 4;
    f16* rr = R1 + (size_t)m * DM + lane * 4;
    f32x4 xv[4];
#pragma unroll
    for (int j = 0; j < 4; ++j) xv[j] = *(const f32x4*)(xr + 256 * j);
    if (gpost) {
      f32x4 yv[4]; float ss = 0.f;
#pragma unroll
      for (int j = 0; j < 4; ++j) { const h4 y = *(const h4*)(rr + 256 * j); yv[j] = (f32x4){(float)y[0], (float)y[1], (float)y[2], (float)y[3]}; ss += yv[j][0] * yv[j][0] + yv[j][1] * yv[j][1] + yv[j][2] * yv[j][2] + yv[j][3] * yv[j][3]; }
      const float rstd = 1.0f / sqrtf(wave_sum(ss) * (1.0f / DM) + RMS_EPS);
#pragma unroll
      for (int j = 0; j < 4; ++j) xv[j] = xv[j] + yv[j] * rstd * gp[j];
    }
    float* xo = X + (size_t)m * DM + lane * 4;
#pragma unroll
    for (int j = 0; j < 4; ++j) *(f32x4*)(xo + 256 * j) = xv[j];
    if (gpre) {
      float ss = 0.f;
#pragma unroll
      for (int j = 0; j < 4; ++j) ss += xv[j][0] * xv[j][0] + xv[j][1] * xv[j][1] + xv[j][2] * xv[j][2] + xv[j][3] * xv[j][3];
      const float rstd = 1.0f / sqrtf(wave_sum(ss) * (1.0f / DM) + RMS_EPS);
#pragma unroll
      for (int j = 0; j < 4; ++j) { const f32x4 h = xv[j] * rstd * gq[j]; u32x2 w; w.x = pk_f16(h[0], h[1]); w.y = pk_f16(h[2], h[3]); *(u32x2*)(rr + 256 * j) = w; }
    }
  }
}

__device__ __forceinline__ void pool_phase(int vcu, int G, const f16* U, f16* P, const int tid, int tile_pm, int tile_pn) {
  const int id0 = tile_pm >= 0 ? ((tile_pm * 16 + (tid >> 5)) << 7) + tile_pn * 32 + (tid & 31) : vcu * 512 + tid;
  const int idstep = tile_pm >= 0 ? (M / 16) * 128 : G * 512;
#pragma unroll 1
  for (int id = id0; id < (M / 16) * 128; id += idstep) {
    const int chunk = id & 127, run = id >> 7, grp = chunk >> 5, w = 2 << grp;
    const int row0 = run * 16, t0 = row0 & (SEQ - 1);
    const f16* up = U + (size_t)row0 * DM + chunk * 8;
    f16* pp = P + (size_t)row0 * DM + chunk * 8;
    float sum[8];
#pragma unroll
    for (int e = 0; e < 8; ++e) sum[e] = 0.f;
    for (int k = 1; k < w; ++k) {
      if (t0 - k >= 0) { const h8 v = *(const h8*)(up - (size_t)k * DM);
#pragma unroll
        for (int e = 0; e < 8; ++e) sum[e] += (float)v[e]; }
    }
    for (int i = 0; i < 16; ++i) {
      const int t = t0 + i;
      const h8 cur = *(const h8*)(up + (size_t)i * DM);
      const float rc = 1.0f / (float)(t + 1 < w ? t + 1 : w);
      float o[8];
#pragma unroll
      for (int e = 0; e < 8; ++e) { sum[e] += (float)cur[e]; o[e] = sum[e] * rc - (float)cur[e]; }
      u32x4 wv; wv.x = pk_f16(o[0], o[1]); wv.y = pk_f16(o[2], o[3]); wv.z = pk_f16(o[4], o[5]); wv.w = pk_f16(o[6], o[7]);
      *(u32x4*)(pp + (size_t)i * DM) = wv;
      if (t - w + 1 >= 0) { const h8 old = *(const h8*)(up + (size_t)(i - w + 1) * DM);
#pragma unroll
        for (int e = 0; e < 8; ++e) sum[e] -= (float)old[e]; }
    }
  }
}

__device__ __forceinline__ void conv_matrix(const float* W, int K, int N, f16* WT, int ldk, int& off, int gw, int NGW, int lane, LAS unsigned char* stg) {
  const int nblk = N / 64, nitems = (K / 64) * nblk;
  int first = gw - (off % NGW); if (first < 0) first += NGW;
#pragma unroll 1
  for (int item = first; item < nitems; item += NGW) {
    const int kb = item / nblk, nb = item % nblk, k0 = 64 * kb, n0 = 64 * nb;
    const float* src = W + (size_t)k0 * N + n0 + lane;
    float v[64];
#pragma unroll
    for (int j = 0; j < 64; ++j) v[j] = __builtin_nontemporal_load(src + (size_t)j * N);
#pragma unroll
    for (int q = 0; q < 8; ++q) { u32x4 o; o.x = pk_f16(v[8 * q], v[8 * q + 1]); o.y = pk_f16(v[8 * q + 2], v[8 * q + 3]); o.z = pk_f16(v[8 * q + 4], v[8 * q + 5]); o.w = pk_f16(v[8 * q + 6], v[8 * q + 7]);
      *(LAS u32x4*)(stg + lane * 144 + q * 16) = o; }
    asm volatile("s_waitcnt lgkmcnt(0)" ::: "memory");
    f16* dst = WT + (size_t)(n0 + (lane >> 3)) * ldk + k0 + (lane & 7) * 8;
#pragma unroll
    for (int i = 0; i < 8; ++i) {
      const u32x4 o = *(const LAS u32x4*)(stg + (8 * i + (lane >> 3)) * 144 + (lane & 7) * 16);
      *(u32x4*)(dst + (size_t)(8 * i) * ldk) = o;
    }
    asm volatile("s_waitcnt lgkmcnt(0)" ::: "memory");
  }
  off += nitems;
}

__device__ const double INV_FREQ[16] = {
  1.0, 0.44036660267178046, 0.19392274474868576, 0.08539710028576561, 0.03760603093086393, 0.016560440080994446,
  0.007292664737217109, 0.003211445994752591, 0.001414213562373095, 0.000622772421914596, 0.0002742481756762073,
  0.00012076973741146504, 5.318295896944988e-05, 2.341999896140934e-05, 1.031338537721246e-05, 4.5416704806078695e-06 };

struct Args { const float* in[14]; float* out; unsigned char* ws; int ph_lo, ph_hi; };

__device__ __forceinline__ void conv_layer(const Args& a, int i, int& scr, int gw, int NGW, int lane, LAS unsigned char* stg) {
  unsigned char* wb = a.ws + WS_W; const int j = i >> 1;
  if ((i & 1) == 0) {
    conv_matrix(a.in[4] + (size_t)j * DM * DM, DM, DM, (f16*)(wb + WP_IN), DM, scr, gw, NGW, lane, stg);
    for (int g = 0; g < 4; ++g) conv_matrix(a.in[5] + (size_t)(j * 4 + g) * 65536, 256, 256, (f16*)(wb + WP_GRP) + g * 65536, 256, scr, gw, NGW, lane, stg);
    conv_matrix(a.in[9] + (size_t)i * DM * DM, DM, DM, (f16*)(wb + WP_XQ), DM, scr, gw, NGW, lane, stg);
    conv_matrix(a.in[11] + (size_t)i * DM * DM, DM, DM, (f16*)(wb + WP_XO), DM, scr, gw, NGW, lane, stg);
    conv_matrix(a.in[12] + (size_t)i * DM * DFF, DM, DFF, (f16*)(wb + WP_W1), DM, scr, gw, NGW, lane, stg);
    conv_matrix(a.in[13] + (size_t)i * DFF * DM, DFF, DM, (f16*)(wb + WP_W2), DFF, scr, gw, NGW, lane, stg);
  } else {
    conv_matrix(a.in[7] + (size_t)j * DM * 3 * DM, DM, 3 * DM, (f16*)(wb + WM_QKV), DM, scr, gw, NGW, lane, stg);
    conv_matrix(a.in[8] + (size_t)j * DM * DM, DM, DM, (f16*)(wb + WM_O), DM, scr, gw, NGW, lane, stg);
    conv_matrix(a.in[9] + (size_t)i * DM * DM, DM, DM, (f16*)(wb + WM_XQ), DM, scr, gw, NGW, lane, stg);
    conv_matrix(a.in[11] + (size_t)i * DM * DM, DM, DM, (f16*)(wb + WM_XO), DM, scr, gw, NGW, lane, stg);
    conv_matrix(a.in[12] + (size_t)i * DM * DFF, DM, DFF, (f16*)(wb + WM_W1), DM, scr, gw, NGW, lane, stg);
    conv_matrix(a.in[13] + (size_t)i * DFF * DM, DFF, DM, (f16*)(wb + WM_W2), DFF, scr, gw, NGW, lane, stg);
  }
}

constexpr int NPHASE = 2 + 11 * DEPTH;

__global__ void __launch_bounds__(512, 2) mega_fwd(Args a) {
  extern __shared__ __attribute__((aligned(16))) unsigned char lds_raw[];
  LAS unsigned char* lds = (LAS unsigned char*)lds_raw;
  const int G = gridDim.x, bx = blockIdx.x;
  const int vcu = (G % 8 == 0) ? (bx % 8) * (G / 8) + bx / 8 : bx;
  const int NGW = G * 8;

  volatile LAS unsigned* MISC = (volatile LAS unsigned*)(lds + 131072);
  if (threadIdx.x < 16) MISC[threadIdx.x] = 0u;
  __syncthreads();
  const XcdBarrier xbar = xcd_barrier_post((unsigned*)(a.ws + WS_BAR), MISC + 8);
  int nrun = 0;
#if TPROBE
  unsigned long long tacc = 0ull, t_end = __builtin_amdgcn_s_memrealtime();
#endif
#pragma unroll 1
  for (int ph = a.ph_lo; ph < a.ph_hi; ++ph) {
    unsigned long long wsi = (unsigned long long)a.ws; asm volatile("" : "+s"(wsi));
    unsigned char* ws = (unsigned char*)(__attribute__((address_space(1))) unsigned char*)wsi;
    float* X = a.out;
    f16* R1 = (f16*)(ws + WS_R1);
    f16* BIG = (f16*)(ws + WS_BIG);
    f16* KVM = (f16*)(ws + WS_KVM);
    float* KMEAN = (float*)(ws + WS_KMEAN);
    float* ROPE = (float*)(ws + WS_ROPE);
    const float* gains = a.in[2];
    int tid = threadIdx.x; asm volatile("" : "+v"(tid));
    const int lane = tid & 63, wave = __builtin_amdgcn_readfirstlane(tid >> 6), gw = vcu * 8 + wave;
    int scr = 0;
    LAS unsigned char* stg = lds + wave * 9216;
    enum { K_NONE, K_GEMM, K_EW, K_POOL, K_MOBA, K_XATT, K_PRO, K_CONV };
    int kind = K_NONE;
    GemmDesc g; g.A = nullptr; g.Bt = nullptr; g.lda = DM; g.ldb = DM; g.K = DM; g.nM = M / BM; g.nN = 4; g.mode = GM_NORMAL;
    g.epi = EPI_F16; g.act = 0; g.O = nullptr; g.ldc = DM; g.colscale = nullptr; g.cscale = 1.f; g.rope = ROPE; g.kmean = KMEAN;
    g.fuse = 0; g.want = 0; g.g1 = nullptr; g.g2 = nullptr; g.X = X; g.xslot = (float*)(ws + WS_XSLOT); g.xcnt = (unsigned*)(ws + WS_XCNT);
    const bool fuse = (G == 256);
    const float* ew_post = nullptr; const float* ew_pre = nullptr; int li = 0; bool conv23 = false; bool nobar = false;
    if (ph == 0) kind = K_PRO;
    else if (ph == 1) {
      kind = K_GEMM; g.A = BIG; g.Bt = BIG + 8 * MiB; g.nM = 32; g.nN = 8; g.mode = GM_KVM; g.O = KVM; g.ldc = 2048;
    } else {
      li = (ph - 2) / 11; const int s = (ph - 2) % 11; const bool moba = (li & 1) != 0;
      const f16* wl = (const f16*)(ws + WS_W);
      const float* gl = gains + (size_t)li * 6 * DM;
      switch (s) {
        case 0:
          kind = K_GEMM; g.A = R1;
          if (!moba) { g.Bt = wl + WP_IN / 2; g.O = BIG; }
          else { g.Bt = wl + WM_QKV / 2; g.nN = 12; g.O = BIG; g.ldc = 3 * DM; g.epi = EPI_QKV; g.cscale = 0.08838834764831845f * LOG2E; g.kmean = KMEAN + (size_t)(li >> 1) * 65536; }
          break;
        case 1: kind = moba ? K_MOBA : K_POOL; break;
        case 2:
          kind = K_GEMM; g.O = R1;
          if (!moba) { g.A = BIG + 16 * MiB; g.Bt = wl + WP_GRP / 2; g.ldb = 256; g.K = 256; g.mode = GM_GROUPED; g.colscale = a.in[6] + (size_t)(li >> 1) * DM; nobar = fuse; }
          else { g.A = BIG + 48 * MiB; g.Bt = wl + WM_O / 2; }
          if (fuse) { g.fuse = 1; g.g1 = gl + 1 * DM; g.g2 = gl + 2 * DM; g.want = 32u * (unsigned)(li * 3 + 1); }
          break;
        case 3: kind = fuse ? K_NONE : K_EW; ew_post = gl + 1 * DM; ew_pre = gl + 2 * DM; break;
        case 4: kind = K_GEMM; g.A = R1; g.Bt = wl + (moba ? WM_XQ : WP_XQ) / 2; g.O = BIG; g.cscale = 0.0625f * LOG2E; break;
        case 5: kind = K_XATT; nobar = fuse; break;
        case 6: kind = K_GEMM; g.A = BIG + 16 * MiB; g.Bt = wl + (moba ? WM_XO : WP_XO) / 2; g.O = R1;
          if (fuse) { g.fuse = 1; g.g1 = gl + 3 * DM; g.g2 = gl + 4 * DM; g.want = 32u * (unsigned)(li * 3 + 2); }
          break;
        case 7: kind = fuse ? K_NONE : K_EW; ew_post = gl + 3 * DM; ew_pre = gl + 4 * DM; break;
        case 8: kind = K_GEMM; g.A = R1; g.Bt = wl + (moba ? WM_W1 : WP_W1) / 2; g.nN = 16; g.O = BIG; g.ldc = DFF; g.act = 1; break;
        case 9: kind = K_GEMM; g.A = BIG; g.lda = DFF; g.Bt = wl + (moba ? WM_W2 : WP_W2) / 2; g.ldb = DFF; g.K = DFF; g.O = R1;
          if (fuse) { g.fuse = 1; g.g1 = gl + 5 * DM; g.g2 = (li + 1 < DEPTH) ? gl + 6 * DM : nullptr; g.want = 32u * (unsigned)(li * 3 + 3); }
          break;
        default: conv23 = (li == 1); kind = fuse ? (conv23 ? K_CONV : K_NONE) : K_EW; ew_post = gl + 5 * DM; ew_pre = (li + 1 < DEPTH) ? gl + 6 * DM : nullptr; break;
      }
    }

    if (kind == K_NONE) continue;
    if (nrun > 0) {
      if (a.ph_lo < 0) cg::this_grid().sync();
      if (nobar) { asm volatile("s_waitcnt vmcnt(0)" ::: "memory"); __syncthreads(); }
      else { xcd_barrier(xbar);
#if PROBE == 3
        xcd_barrier(xbar); xcd_barrier(xbar);
#endif
      }
    }
    ++nrun;
#if TPROBE
    const unsigned long long t0 = __builtin_amdgcn_s_memrealtime();
    if (TPROBE == 1) tacc += t0 - t_end;
#endif
    if (kind == K_GEMM) {
#if PROBE == 1
#pragma unroll 1
      for (int rep = 0; rep < 2; ++rep) { gemm_phase(lds, g, G, bx, tid); __syncthreads(); g.kmean = nullptr; }
#else
      gemm_phase(lds, g, G, bx, tid);
#endif
    } else if (kind == K_EW) {
      ew_phase(vcu, G, wave, lane, nullptr, X, R1, ew_post, ew_pre);
#if PROBE == 4
      if (ew_pre) { __syncthreads(); ew_phase(vcu, G, wave, lane, nullptr, X, R1, nullptr, ew_pre); }
#endif
#if PROBE == 5
      for (int rep = 0; rep < 2; ++rep)
#endif
      if (conv23) { conv_layer(a, 2, scr, gw, NGW, lane, stg); conv_layer(a, 3, scr, gw, NGW, lane, stg); }
    } else if (kind == K_CONV) {
      conv_layer(a, 2, scr, gw, NGW, lane, stg); conv_layer(a, 3, scr, gw, NGW, lane, stg);
    } else if (kind == K_POOL) {
#if PROBE == 6
      for (int rep = 0; rep < 2; ++rep)
#endif
      { int tpm = -1, tpn = 0; if (fuse) { Unit up; (void)sched_next(g, G, bx, 0, up); tpm = up.pm; tpn = up.pn; }
        pool_phase(vcu, G, BIG, BIG + 16 * MiB, tid, tpm, tpn); }
    } else if (kind == K_MOBA) {
      const float* km = KMEAN + (size_t)(li >> 1) * 65536;
#if PROBE == 2
      for (int rep = 0; rep < 2; ++rep)
#endif
      for (int uid = vcu; uid < 512; uid += G) {
        const int bh = (uid & 255) >> 2, qb = (uid < 256) ? (uid & 3) : 7 - (uid & 3), b = bh >> 3, h = bh & 7;
        const f16* base = BIG + (size_t)b * SEQ * 3 * DM + h * 128;
        attn_unit<128, true>(lds, base + (size_t)qb * 256 * 3 * DM, 3 * DM, base + DM, base + 2 * DM, 3 * DM,
                             BIG + 48 * MiB + (size_t)(b * SEQ + qb * 256) * DM + h * 128, DM, qb, km + (size_t)bh * 8 * 128, tid);
      }
    } else if (kind == K_XATT) {
#if PROBE == 2
      for (int rep = 0; rep < 2; ++rep)
#endif
      for (int uid = vcu; uid < 256; uid += G) {
        int b = uid >> 5, h = (uid >> 3) & 3, qt = uid & 7;
        if (fuse) { Unit u; (void)sched_next(g, G, bx, 0, u); b = u.pm >> 3; qt = u.pm & 7; h = u.pn; }
        const f16* kv = KVM + (size_t)li * 2048 * 2048 + (size_t)b * NMEM * 2048 + h * 256;
        xatt_unit(lds, BIG + (size_t)(b * SEQ + qt * 256) * DM + h * 256, kv, kv + DM, BIG + 16 * MiB + (size_t)(b * SEQ + qt * 256) * DM + h * 256, tid);
      }
    } else if (kind == K_PRO) {
#if PROBE == 5
      for (int rep = 0; rep < 2; ++rep) {
#else
      {
#endif
      conv_layer(a, 0, scr, gw, NGW, lane, stg); conv_layer(a, 1, scr, gw, NGW, lane, stg);
      for (int i = 0; i < DEPTH; ++i) conv_matrix(a.in[10] + (size_t)i * DM * 2 * DM, DM, 2 * DM, BIG + 8 * MiB + (size_t)i * 2048 * DM, DM, scr, gw, NGW, lane, stg);
      }
#pragma unroll 1
      for (int r = gw; r < BATCH * NMEM; r += NGW) {
        const float* mr = a.in[1] + (size_t)r * DM + lane * 4; f32x4 v[4]; float ss = 0.f;
#pragma unroll
        for (int j = 0; j < 4; ++j) { v[j] = *(const f32x4*)(mr + 256 * j); ss += v[j][0] * v[j][0] + v[j][1] * v[j][1] + v[j][2] * v[j][2] + v[j][3] * v[j][3]; }
        const float rstd = 1.0f / sqrtf(wave_sum(ss) * (1.0f / DM) + RMS_EPS);
        for (int i = 0; i < DEPTH; ++i) {
          const float* gm = a.in[3] + (size_t)i * DM + lane * 4; f16* orow = BIG + ((size_t)i * 2048 + r) * DM + lane * 4;
#pragma unroll
          for (int j = 0; j < 4; ++j) { const f32x4 gg = *(const f32x4*)(gm + 256 * j); const f32x4 h = v[j] * rstd * gg; u32x2 w; w.x = pk_f16(h[0], h[1]); w.y = pk_f16(h[2], h[3]); *(u32x2*)(orow + 256 * j) = w; }
        }
      }
#pragma unroll 1
      for (int id = vcu * 512 + tid; id < SEQ * 16; id += G * 512) {
        const int pos = id >> 4, i = id & 15;
        const double rev = (double)pos * INV_FREQ[i] * 0.15915494309189535;
        const float fr = (float)(rev - (double)(long long)rev);
        ROPE[id] = __builtin_amdgcn_cosf(fr); ROPE[SEQ * 16 + id] = __builtin_amdgcn_sinf(fr); asm volatile("" : "+v"(id));
      }
      { float* xs = (float*)(ws + WS_XSLOT); for (int id = vcu * 512 + tid; id < 2 * M * 8; id += G * 512) { xs[id] = 0.f; asm volatile("" : "+v"(id)); } }
      for (int id = vcu * 512 + tid; id < 2 * 65536; id += G * 512) { KMEAN[id] = 0.f; asm volatile("" : "+v"(id)); }
      ew_phase(vcu, G, wave, lane, a.in[0], X, R1, nullptr, gains);
    }
    __syncthreads();
#if TPROBE
    { const unsigned long long t1 = __builtin_amdgcn_s_memrealtime(); t_end = t1;
      int cat = 5;
      if (kind == K_GEMM) { cat = 2; }
      else if (kind == K_MOBA) cat = 3; else if (kind == K_XATT) cat = 4;
      bool hit = (cat == TPROBE);
      if (kind == K_GEMM) {
        if (TPROBE == 6) hit = (g.K == DFF);
        if (TPROBE == 7) hit = (g.nN == 16);
        if (TPROBE == 8) hit = (g.nN == 12);
        if (TPROBE == 9) hit = (g.nN == 4 && g.K == DM && g.mode == GM_NORMAL);
        if (TPROBE == 10) hit = (g.mode == GM_GROUPED);
        if (TPROBE == 12) hit = (g.mode == GM_KVM);
      }
      if (TPROBE == 11) hit = (kind == K_PRO);
      if (TPROBE == 13) hit = (kind == K_CONV);
      if (TPROBE == 14) hit = (kind == K_POOL);
      if (hit) tacc += t1 - t0; }
#endif
  }
#if TPROBE
  if (bx == 0) { const unsigned long long ts = __builtin_amdgcn_s_memrealtime(); while (__builtin_amdgcn_s_memrealtime() - ts < 3ull * tacc) __builtin_amdgcn_s_sleep(8); }
#endif
}

extern "C" void kernel_launch(void* const* d_in, const int* in_sizes, int n_in, void* d_out, int out_size, void* d_ws, size_t ws_size, hipStream_t stream) {
  static int grid = 0;
  if (grid == 0) {
    int dev = 0, cus = 0, per_cu = 0;
    hipGetDevice(&dev);
    hipDeviceGetAttribute(&cus, hipDeviceAttributeMultiprocessorCount, dev);
    hipFuncSetAttribute((const void*)mega_fwd, hipFuncAttributeMaxDynamicSharedMemorySize, LDS_BYTES);
    hipOccupancyMaxActiveBlocksPerMultiprocessor(&per_cu, (const void*)mega_fwd, 512, LDS_BYTES);
    if (per_cu < 1) { fprintf(stderr, "occupancy query returned %d\n", per_cu); per_cu = 1; }
    (void)hipGetLastError();
    grid = cus;
    if (ws_size < WS_END) fprintf(stderr, "workspace too small: %zu\n", ws_size);
  }
  (void)hipMemsetAsync((char*)d_ws + WS_BAR, 0, 48 * 1024, stream);
  Args a{};
  for (int i = 0; i < 14; ++i) a.in[i] = (const float*)d_in[i];
  a.out = (float*)d_out; a.ws = (unsigned char*)d_ws;
#if MULTI_LAUNCH
  for (int ph = 0; ph < NPHASE; ++ph) { a.ph_lo = ph; a.ph_hi = ph + 1; hipLaunchKernelGGL(mega_fwd, dim3(grid), dim3(512), LDS_BYTES, stream, a); }
#else
  a.ph_lo = 0; a.ph_hi = NPHASE;
  void* args[] = {&a};
  hipError_t e = hipLaunchCooperativeKernel((const void*)mega_fwd, dim3(grid), dim3(512), args, LDS_BYTES, stream);
  if (e != hipSuccess) fprintf(stderr, "cooperative launch failed: %s (grid %d)\n", hipGetErrorString(e), grid);
#endif
}
```

```cpp
#include <hip/hip_runtime.h>
#include <hip/hip_cooperative_groups.h>
#include <cstdio>
#include <cstdint>
namespace cg = cooperative_groups;

#ifndef PROBE
#define PROBE 0
#endif
#ifndef TPROBE
#define TPROBE 0
#endif
#ifndef MULTI_LAUNCH
#define MULTI_LAUNCH 0
#endif

#define LAS __attribute__((address_space(3)))
typedef _Float16 f16;
typedef _Float16 h8 __attribute__((ext_vector_type(8)));
typedef _Float16 h4 __attribute__((ext_vector_type(4)));
typedef _Float16 h2 __attribute__((ext_vector_type(2)));
typedef short s16x4 __attribute__((ext_vector_type(4)));
typedef float f32x2 __attribute__((ext_vector_type(2)));
typedef float f32x4 __attribute__((ext_vector_type(4)));
typedef float f32x16 __attribute__((ext_vector_type(16)));
typedef unsigned u32x4 __attribute__((ext_vector_type(4)));
typedef unsigned u32x2 __attribute__((ext_vector_type(2)));

constexpr int DM = 1024, BATCH = 8, SEQ = 2048, DEPTH = 4, NMEM = 256, DFF = 4096;
constexpr int M = BATCH * SEQ;
constexpr float RMS_EPS = 1e-6f;
constexpr float LOG2E = 1.4426950408889634f;

constexpr size_t MiB = 1u << 20;
constexpr size_t WS_KMEAN = 0;
constexpr size_t WS_ROPE = 512 * 1024;
constexpr size_t WS_W = 1 * MiB;
constexpr size_t WS_KVM = 60 * MiB;
constexpr size_t WS_R1 = 92 * MiB;
constexpr size_t WS_BIG = 124 * MiB;
constexpr size_t WS_END = 252 * MiB;
constexpr size_t WP_IN = 0, WP_GRP = 2 * MiB, WP_XQ = 3 * MiB, WP_XO = 5 * MiB, WP_W1 = 7 * MiB, WP_W2 = 15 * MiB;
constexpr size_t WM_QKV = 23 * MiB, WM_O = 29 * MiB, WM_XQ = 31 * MiB, WM_XO = 33 * MiB, WM_W1 = 35 * MiB, WM_W2 = 43 * MiB;

constexpr int LDS_BYTES = 131072 + 64;
constexpr size_t WS_BAR = 800 * 1024;
constexpr size_t WS_XCNT = 816 * 1024;
constexpr size_t WS_XSLOT = 52 * MiB;

__device__ __forceinline__ unsigned pk_f16(float lo, float hi) { f32x2 v = {lo, hi}; h2 h = __builtin_convertvector(v, h2); return __builtin_bit_cast(unsigned, h); }
__device__ __forceinline__ float wave_sum(float v) {
#pragma unroll
  for (int o = 1; o < 64; o <<= 1) v += __shfl_xor(v, o);
  return v;
}

constexpr int BM = 256, BK = 64, HALF = 128, HTB = HALF * BK * 2, NXCD = 8, WGM = 4;
__device__ __forceinline__ int lds_byte(int r, int c) { const int st = (r >> 4) * 2 + (c >> 5), rr = r & 15, cc = c & 31, ob = rr * 64 + cc * 2; return st * 1024 + (ob ^ (((ob >> 9) & 1) << 5)); }
__device__ __forceinline__ void stage_rc(int b, int& R, int& C) { const int st = b / 1024, sb = b % 1024, swz = sb ^ (((sb >> 9) & 1) << 5); R = (st >> 1) * 16 + swz / 64; C = (st & 1) * 32 + (swz % 64) / 2; }
__device__ __forceinline__ int perm32(int rho) { const int n = rho >> 4, i = rho & 15; return 8 * (i >> 2) + 4 * n + (i & 3); }

struct Unit { int pm, pn; };
enum { EPI_F16 = 0, EPI_QKV = 1 };
enum { GM_NORMAL = 0, GM_GROUPED = 1, GM_KVM = 2 };
struct GemmDesc {
  const f16* A; const f16* Bt; int lda, ldb, K, nM, nN, mode;
  int epi, act; f16* O; int ldc; const float* colscale; float cscale;
  const float* rope; float* kmean;
  int fuse; unsigned want; const float* g1; const float* g2; float* X; float* xslot; unsigned* xcnt;
};

__device__ __forceinline__ bool sched_next(const GemmDesc& g, int G, int c, int i, Unit& u) {
  const int nM = g.nM, nN = g.nN, nwg = nM * nN;
  const long L = (long)i * G + c; if (L >= nwg) return false;
  int wgid = (int)L; { const int q = nwg / NXCD, r = nwg % NXCD, xcd = wgid % NXCD, off = wgid / NXCD; wgid = (xcd < r ? xcd * (q + 1) : r * (q + 1) + (xcd - r) * q) + off; }
  const int nig = WGM * nN, gid = wgid / nig, fm = gid * WGM, gsz = (nM - fm) < WGM ? (nM - fm) : WGM;
  u.pm = fm + ((wgid % nig) % gsz); u.pn = (wgid % nig) / gsz; return true;
}

__device__ __forceinline__ void gemm_epilogue(const f32x4 (&acc)[2][2][4][2], const GemmDesc& g, const Unit& u, int wr, int wc, int fr, int fq) {
  const int row0 = u.pm * BM + wr * 64 + fr;
  const int col0 = u.pn * BM + wc * 32 + 8 * fq;
  if (g.epi == EPI_F16) {
    float cs[2][8];
#pragma unroll
    for (int bj = 0; bj < 2; ++bj) {
      if (g.colscale) { const f32x4 a = *(const f32x4*)(g.colscale + col0 + bj * HALF), b = *(const f32x4*)(g.colscale + col0 + bj * HALF + 4);
        cs[bj][0] = a[0] * g.cscale; cs[bj][1] = a[1] * g.cscale; cs[bj][2] = a[2] * g.cscale; cs[bj][3] = a[3] * g.cscale;
        cs[bj][4] = b[0] * g.cscale; cs[bj][5] = b[1] * g.cscale; cs[bj][6] = b[2] * g.cscale; cs[bj][7] = b[3] * g.cscale;
      } else {
#pragma unroll
        for (int e = 0; e < 8; ++e) cs[bj][e] = g.cscale;
      }
    }
    const bool act = g.act != 0;
#pragma unroll
    for (int ai = 0; ai < 2; ++ai)
#pragma unroll
      for (int m = 0; m < 4; ++m) {
        f16* rowp = g.O + (size_t)(row0 + ai * HALF + m * 16) * g.ldc + col0;
#pragma unroll
        for (int bj = 0; bj < 2; ++bj) {
          f32x4 v0 = acc[ai][bj][m][0], v1 = acc[ai][bj][m][1];
          if (act) {
#pragma unroll
            for (int e = 0; e < 4; ++e) { float a = fmaxf(v0[e], 0.f); v0[e] = a * a; float b = fmaxf(v1[e], 0.f); v1[e] = b * b; }
          }
          u32x4 w;
          w.x = pk_f16(v0[0] * cs[bj][0], v0[1] * cs[bj][1]); w.y = pk_f16(v0[2] * cs[bj][2], v0[3] * cs[bj][3]);
          w.z = pk_f16(v1[0] * cs[bj][4], v1[1] * cs[bj][5]); w.w = pk_f16(v1[2] * cs[bj][6], v1[3] * cs[bj][7]);
          *(u32x4*)(rowp + bj * HALF) = w;
        }
      }
  } else {
    const int which = u.pn >> 2;
    const bool dorope = (which < 2) && (wc == 0);
    const float qs = (which == 0) ? g.cscale : 1.f;
    float ksum[2][8];
#pragma unroll
    for (int bj = 0; bj < 2; ++bj)
#pragma unroll
      for (int e = 0; e < 8; ++e) ksum[bj][e] = 0.f;
#pragma unroll
    for (int ai = 0; ai < 2; ++ai)
#pragma unroll
      for (int m = 0; m < 4; ++m) {
        const int row = row0 + ai * HALF + m * 16;
        f16* rowp = g.O + (size_t)row * g.ldc + col0;
        float cv[8], sv[8];
        if (dorope) {
          const float* rp = g.rope + (size_t)(row & (SEQ - 1)) * 16 + 8 * (fq & 1);
          const f32x4 c0 = *(const f32x4*)rp, c1 = *(const f32x4*)(rp + 4), s0 = *(const f32x4*)(rp + SEQ * 16), s1 = *(const f32x4*)(rp + SEQ * 16 + 4);
          const float sg = (fq < 2) ? -1.f : 1.f;
#pragma unroll
          for (int e = 0; e < 4; ++e) { cv[e] = c0[e]; cv[4 + e] = c1[e]; sv[e] = s0[e] * sg; sv[4 + e] = s1[e] * sg; }
        }
#pragma unroll
        for (int bj = 0; bj < 2; ++bj) {
          float v[8];
#pragma unroll
          for (int e = 0; e < 4; ++e) { v[e] = acc[ai][bj][m][0][e]; v[4 + e] = acc[ai][bj][m][1][e]; }
          if (dorope) {
#pragma unroll
            for (int e = 0; e < 8; ++e) { const float p = __shfl_xor(v[e], 32); v[e] = v[e] * cv[e] + p * sv[e]; }
          }
          if (which == 1) {
#pragma unroll
            for (int e = 0; e < 8; ++e) ksum[bj][e] += v[e];
          }
          u32x4 w;
          w.x = pk_f16(v[0] * qs, v[1] * qs); w.y = pk_f16(v[2] * qs, v[3] * qs); w.z = pk_f16(v[4] * qs, v[5] * qs); w.w = pk_f16(v[6] * qs, v[7] * qs);
          *(u32x4*)(rowp + bj * HALF) = w;
        }
      }
    if (which == 1 && g.kmean) {
      const int b = u.pm >> 3, blk = u.pm & 7;
#pragma unroll
      for (int bj = 0; bj < 2; ++bj) {
        const int head = 2 * (u.pn & 3) + bj;
        float* kp = g.kmean + ((size_t)((b * 8 + head) * 8 + blk)) * 128 + wc * 32 + 8 * fq;
#pragma unroll
        for (int e = 0; e < 8; ++e) {
          float s = ksum[bj][e];
          s += __shfl_xor(s, 1); s += __shfl_xor(s, 2); s += __shfl_xor(s, 4); s += __shfl_xor(s, 8);
          if (fr == 0) atomicAdd(kp + e, s);
        }
      }
    }
  }
}


__device__ __forceinline__ void panel_rstd(const f32x4 (&v)[2][2][4][2], const Unit& u, int wr, int wc, int fr, int fq, LAS unsigned char* lds, int wid, int lane,
                                           float* slots, unsigned* cnt, unsigned want) {
  LAS float* P = (LAS float*)lds; LAS float* S = (LAS float*)(lds + 4096);
#pragma unroll
  for (int ai = 0; ai < 2; ++ai)
#pragma unroll
    for (int m = 0; m < 4; ++m) {
      float q = 0.f;
#pragma unroll
      for (int bj = 0; bj < 2; ++bj)
#pragma unroll
        for (int n = 0; n < 2; ++n) { const f32x4 x = v[ai][bj][m][n]; q += (x[0] * x[0] + x[1] * x[1]) + (x[2] * x[2] + x[3] * x[3]); }
      q += __shfl_xor(q, 16); q += __shfl_xor(q, 32);
      if (fq == 0) P[(ai * HALF + wr * 64 + m * 16 + fr) * 4 + wc] = q;
    }
  asm volatile("s_waitcnt lgkmcnt(0)" ::: "memory"); __builtin_amdgcn_s_barrier(); asm volatile("" ::: "memory");
  const int row = wid * 32 + (lane & 31);
  if (lane < 32) {
    const f32x4 p = *(const LAS f32x4*)(P + row * 4);
    const float mine = (p[0] + p[1]) + (p[2] + p[3]);
    unsigned long long* sl = (unsigned long long*)slots + (size_t)(u.pm * BM + row) * 4;
    __hip_atomic_store(sl + u.pn, ((unsigned long long)want << 32) | __float_as_uint(mine), __ATOMIC_RELAXED, __HIP_MEMORY_SCOPE_AGENT);
    float t = 0.f;
#pragma unroll
    for (int k = 0; k < 4; ++k) {
      float val = mine;
      if (k != u.pn) {
        unsigned sp = 0;
        for (;;) {
          const unsigned long long w = __hip_atomic_load(sl + k, __ATOMIC_RELAXED, __HIP_MEMORY_SCOPE_AGENT);
          if ((unsigned)(w >> 32) == want) { val = __uint_as_float((unsigned)w); break; }
          if (++sp > (1u << 22)) break;
          __builtin_amdgcn_s_sleep(1);
        }
      }
      t += val;
    }
    S[row] = 1.0f / sqrtf(t * (1.0f / DM) + RMS_EPS);
  }
  asm volatile("s_waitcnt vmcnt(0) lgkmcnt(0)" ::: "memory"); __builtin_amdgcn_s_barrier(); asm volatile("" ::: "memory");
}
__device__ __forceinline__ void fused_epilogue(f32x4 (&acc)[2][2][4][2], const GemmDesc& g, const Unit& u, int wr, int wc, int fr, int fq, LAS unsigned char* lds, int wid, int lane) {
  const LAS float* S = (const LAS float*)(lds + 4096);
  const int col0 = u.pn * BM + wc * 32 + 8 * fq;
  if (g.colscale) {
#pragma unroll
    for (int bj = 0; bj < 2; ++bj) {
      const f32x4 c0 = *(const f32x4*)(g.colscale + col0 + bj * HALF), c1 = *(const f32x4*)(g.colscale + col0 + bj * HALF + 4);
#pragma unroll
      for (int ai = 0; ai < 2; ++ai)
#pragma unroll
        for (int m = 0; m < 4; ++m) { acc[ai][bj][m][0] = acc[ai][bj][m][0] * c0; acc[ai][bj][m][1] = acc[ai][bj][m][1] * c1; }
    }
  }
  f32x4 xpre[4][2][2];
#pragma unroll
  for (int m = 0; m < 4; ++m) { const float* xp = g.X + (size_t)(u.pm * BM + wr * 64 + m * 16 + fr) * DM + col0;
#pragma unroll
    for (int bj = 0; bj < 2; ++bj) { xpre[m][bj][0] = *(const f32x4*)(xp + bj * HALF); xpre[m][bj][1] = *(const f32x4*)(xp + bj * HALF + 4); } }
  panel_rstd(acc, u, wr, wc, fr, fq, lds, wid, lane, g.xslot, g.xcnt, g.want);
  {
    f32x4 ga[2][2];
#pragma unroll
    for (int bj = 0; bj < 2; ++bj) { ga[bj][0] = *(const f32x4*)(g.g1 + col0 + bj * HALF); ga[bj][1] = *(const f32x4*)(g.g1 + col0 + bj * HALF + 4); }
#pragma unroll
    for (int ai = 0; ai < 2; ++ai)
#pragma unroll
      for (int m = 0; m < 4; ++m) {
        const int r = ai * HALF + wr * 64 + m * 16 + fr; const float sr = S[r];
        const float* xp = g.X + (size_t)(u.pm * BM + r) * DM + col0;
#pragma unroll
        for (int bj = 0; bj < 2; ++bj) {
          const f32x4 x0 = ai == 0 ? xpre[m][bj][0] : *(const f32x4*)(xp + bj * HALF), x1 = ai == 0 ? xpre[m][bj][1] : *(const f32x4*)(xp + bj * HALF + 4);
          acc[ai][bj][m][0] = x0 + acc[ai][bj][m][0] * sr * ga[bj][0]; acc[ai][bj][m][1] = x1 + acc[ai][bj][m][1] * sr * ga[bj][1];
        }
      }
  }
  if (g.g2) {
    panel_rstd(acc, u, wr, wc, fr, fq, lds, wid, lane, g.xslot + (size_t)M * 8, g.xcnt + 64 * 64, g.want);
    f32x4 gb[2][2];
#pragma unroll
    for (int bj = 0; bj < 2; ++bj) { gb[bj][0] = *(const f32x4*)(g.g2 + col0 + bj * HALF); gb[bj][1] = *(const f32x4*)(g.g2 + col0 + bj * HALF + 4); }
#pragma unroll
    for (int ai = 0; ai < 2; ++ai)
#pragma unroll
      for (int m = 0; m < 4; ++m) {
        const int r = ai * HALF + wr * 64 + m * 16 + fr; const float sr = S[r];
        float* xp = g.X + (size_t)(u.pm * BM + r) * DM + col0;
        f16* hp = g.O + (size_t)(u.pm * BM + r) * DM + col0;
#pragma unroll
        for (int bj = 0; bj < 2; ++bj) {
          const f32x4 a0 = acc[ai][bj][m][0], a1 = acc[ai][bj][m][1];
          *(f32x4*)(xp + bj * HALF) = a0; *(f32x4*)(xp + bj * HALF + 4) = a1;
          const f32x4 h0 = a0 * sr * gb[bj][0], h1 = a1 * sr * gb[bj][1];
          u32x4 w; w.x = pk_f16(h0[0], h0[1]); w.y = pk_f16(h0[2], h0[3]); w.z = pk_f16(h1[0], h1[1]); w.w = pk_f16(h1[2], h1[3]);
          *(u32x4*)(hp + bj * HALF) = w;
        }
      }
  } else {
#pragma unroll
    for (int ai = 0; ai < 2; ++ai)
#pragma unroll
      for (int m = 0; m < 4; ++m) {
        const int r = ai * HALF + wr * 64 + m * 16 + fr;
        float* xp = g.X + (size_t)(u.pm * BM + r) * DM + col0;
#pragma unroll
        for (int bj = 0; bj < 2; ++bj) { *(f32x4*)(xp + bj * HALF) = acc[ai][bj][m][0]; *(f32x4*)(xp + bj * HALF + 4) = acc[ai][bj][m][1]; }
      }
  }
}

__device__ __forceinline__ void gemm_phase(LAS unsigned char* lds, const GemmDesc& g, int G, int c, const int tid) {
  const int wid = __builtin_amdgcn_readfirstlane(tid >> 6), lane = tid & 63, wr = wid >> 2, wc = wid & 3, fr = lane & 15, fq = lane >> 4;
  const int K = g.K, nt = K / BK;
  unsigned voffA[2], voffB[2];
#pragma unroll
  for (int i = 0; i < 2; ++i) { int R, C; stage_rc(tid * 16 + i * 8192, R, C); const int Rb = (R & ~31) + perm32(R & 31);
    voffA[i] = (unsigned)(R * g.lda + C) * 2u; voffB[i] = (unsigned)(Rb * g.ldb + C) * 2u; }
  const size_t kstep = (size_t)(BK * 2);
  const size_t hstepA = (size_t)HALF * g.lda * 2, hstepB = (size_t)HALF * g.ldb * 2;
  const size_t tstepA = 2 * hstepA, tstepB = 2 * hstepB;
  const unsigned ldsw = (unsigned)wid * 1024u;
  const int aoff = lds_byte(wr * 64 + fr, fq * 8), boff = lds_byte(wc * 32 + fr, fq * 8);
#define UA(u) ((size_t)(u).pm * tstepA + (g.mode == GM_GROUPED ? (size_t)(u).pn * 512 : 0))
#define UB(u) ((size_t)(g.mode == GM_KVM ? (((u).pm >> 3) * 8 + (u).pn) : (u).pn) * tstepB)
#define PG8_SA(b, h) (((b) * 2 + (h)) * HTB)
#define PG8_SB(b, h) ((4 + (b) * 2 + (h)) * HTB)
#define PG8_STAGE(bufoff, gbase, voff) do { _Pragma("unroll") for (int _i = 0; _i < 2; ++_i) \
    __builtin_amdgcn_global_load_lds((const unsigned*)((const char*)(gbase) + (voff)[_i]), (LAS unsigned*)(lds + (bufoff) + ldsw + _i * 8192), 16, 0, 0); } while (0)
#define PG8_LDA(dst, b, h) do { _Pragma("unroll") for (int m = 0; m < 4; ++m) _Pragma("unroll") for (int k = 0; k < 2; ++k) dst[m][k] = *(const LAS h8*)(lds + PG8_SA(b, h) + aoff + m * 2048 + k * 1024); } while (0)
#define PG8_LDB(dst, b, h) do { _Pragma("unroll") for (int n = 0; n < 2; ++n) _Pragma("unroll") for (int k = 0; k < 2; ++k) dst[n][k] = *(const LAS h8*)(lds + PG8_SB(b, h) + boff + n * 2048 + k * 1024); } while (0)
#define PG8_MMA(ai, bj, At, Bt) do { __builtin_amdgcn_s_setprio(1); _Pragma("unroll") for (int m = 0; m < 4; ++m) _Pragma("unroll") for (int n = 0; n < 2; ++n) _Pragma("unroll") for (int k = 0; k < 2; ++k) \
    acc[ai][bj][m][n] = __builtin_amdgcn_mfma_f32_16x16x32_f16(Bt[n][k], At[m][k], acc[ai][bj][m][n], 0, 0, 0); __builtin_amdgcn_s_setprio(0); } while (0)
#define PG8_WAIT_V(n) asm volatile("s_waitcnt vmcnt(" #n ")" ::: "memory")
#define PG8_WAIT_L(n) asm volatile("s_waitcnt lgkmcnt(" #n ")" ::: "memory")
#define PG8_BAR __builtin_amdgcn_s_barrier()
#define PG8_SCHED __builtin_amdgcn_sched_barrier(0)
  Unit cur, nxt; int ui = 0;
  if (!sched_next(g, G, c, 0, cur)) return;
  f32x4 acc[2][2][4][2];
#pragma unroll
  for (int a = 0; a < 2; ++a)
#pragma unroll
    for (int b = 0; b < 2; ++b)
#pragma unroll
      for (int m = 0; m < 4; ++m)
#pragma unroll
        for (int n = 0; n < 2; ++n) acc[a][b][m][n] = (f32x4){0.f, 0.f, 0.f, 0.f};
  h8 At[4][2], B0[2][2], B1[2][2];
  const char* cA = (const char*)g.A + UA(cur); const char* cB = (const char*)g.Bt + UB(cur);
  PG8_STAGE(PG8_SB(0, 0), cB, voffB); PG8_STAGE(PG8_SB(0, 1), cB + hstepB, voffB); PG8_STAGE(PG8_SA(0, 0), cA, voffA); PG8_STAGE(PG8_SA(0, 1), cA + hstepA, voffA);
  if (wr == 1) PG8_BAR;
  PG8_WAIT_V(2); PG8_BAR;
  PG8_STAGE(PG8_SB(1, 0), cB + kstep, voffB); PG8_STAGE(PG8_SA(1, 0), cA + kstep, voffA); PG8_STAGE(PG8_SB(1, 1), cB + hstepB + kstep, voffB);
  PG8_WAIT_V(6); PG8_BAR;
  for (;;) {
    const bool has_next = sched_next(g, G, c, ui + 1, nxt);
    const char* nA = has_next ? (const char*)g.A + UA(nxt) : cA; const char* nB = has_next ? (const char*)g.Bt + UB(nxt) : cB;
    for (int t = 0; t < nt; t += 2) {
      const bool last = (t == nt - 2);
      const char* a1 = cA + (size_t)(t + 1) * kstep;
      const char* a2 = last ? nA : cA + (size_t)(t + 2) * kstep; const char* b2 = last ? nB : cB + (size_t)(t + 2) * kstep;
      const char* a3 = a2 + kstep; const char* b3 = b2 + kstep;
      PG8_LDB(B0, 0, 0); PG8_LDB(B1, 0, 1); PG8_SCHED; PG8_LDA(At, 0, 0); PG8_STAGE(PG8_SA(1, 1), a1 + hstepA, voffA);
      PG8_WAIT_V(8); PG8_WAIT_L(0); PG8_BAR; PG8_MMA(0, 0, At, B0); PG8_MMA(0, 1, At, B1); PG8_BAR; PG8_SCHED;
      PG8_LDA(At, 0, 1); PG8_STAGE(PG8_SB(0, 0), b2, voffB); PG8_STAGE(PG8_SB(0, 1), b2 + hstepB, voffB); PG8_STAGE(PG8_SA(0, 0), a2, voffA);
      PG8_WAIT_V(8); PG8_WAIT_L(0); PG8_BAR; PG8_MMA(1, 0, At, B0); PG8_MMA(1, 1, At, B1); PG8_BAR; PG8_SCHED;
      PG8_LDB(B0, 1, 0); PG8_LDB(B1, 1, 1); PG8_SCHED; PG8_LDA(At, 1, 0); PG8_STAGE(PG8_SA(0, 1), a2 + hstepA, voffA);
      PG8_WAIT_V(8); PG8_WAIT_L(0); PG8_BAR; PG8_MMA(0, 0, At, B0); PG8_MMA(0, 1, At, B1); PG8_BAR; PG8_SCHED;
      PG8_LDA(At, 1, 1); PG8_STAGE(PG8_SB(1, 0), b3, voffB); PG8_STAGE(PG8_SB(1, 1), b3 + hstepB, voffB); PG8_STAGE(PG8_SA(1, 0), a3, voffA);
      PG8_WAIT_V(8); PG8_WAIT_L(0); PG8_BAR; PG8_MMA(1, 0, At, B0); PG8_MMA(1, 1, At, B1); PG8_BAR; PG8_SCHED;
    }
    if (wr == 0) PG8_BAR;
    if (!g.fuse) { int t2 = threadIdx.x; asm volatile("" : "+v"(t2)); gemm_epilogue(acc, g, cur, wr, wc, t2 & 15, (t2 & 63) >> 4); }
    if (!has_next) break;
#pragma unroll
    for (int a = 0; a < 2; ++a)
#pragma unroll
      for (int b = 0; b < 2; ++b)
#pragma unroll
        for (int m = 0; m < 4; ++m)
#pragma unroll
          for (int n = 0; n < 2; ++n) acc[a][b][m][n] = (f32x4){0.f, 0.f, 0.f, 0.f};
    cur = nxt; cA = nA; cB = nB; ++ui;
    if (wr == 1) PG8_BAR;
  }
  PG8_WAIT_V(0);
  PG8_BAR;
  if (g.fuse) { int t2 = threadIdx.x; asm volatile("" : "+v"(t2)); fused_epilogue(acc, g, cur, wr, wc, t2 & 15, (t2 & 63) >> 4, lds, wid, t2 & 63); }
#undef UA
#undef UB
#undef PG8_SA
#undef PG8_SB
#undef PG8_STAGE
#undef PG8_LDA
#undef PG8_LDB
#undef PG8_MMA
#undef PG8_WAIT_V
#undef PG8_WAIT_L
#undef PG8_BAR
#undef PG8_SCHED
}

__device__ __forceinline__ s16x4 vtr(const LAS unsigned char* p) { return __builtin_amdgcn_ds_read_tr16_b64_v4i16((LAS s16x4*)p); }

template <int HD, bool MOBA>
__device__ __forceinline__ void attn_unit(LAS unsigned char* lds, const f16* Qg, int ldq, const f16* Kg, const f16* Vg, int ldkv,
                                          f16* Og, int ldo, int qb, const float* kmg, const int tid) {
  constexpr int KS = HD * 2 + 16, VS = 320, KT_BYTES = 64 * KS, VT_BYTES = 64 * VS;
  constexpr int NSTEP = HD / 16, NPASS = HD / 128, KCH = HD / 8, KPT = 64 * KCH / 512, VPT = 2;
  constexpr int BUFB = KT_BYTES + VT_BYTES;
  LAS unsigned char* Kl = lds; LAS unsigned char* Vl = lds + KT_BYTES; LAS float* kml = (LAS float*)(lds + 2 * BUFB);
  const int lane = tid & 63, wid = __builtin_amdgcn_readfirstlane(tid >> 6), r32 = lane & 31, hi = lane >> 5;
  const float NEG = -INFINITY;
  constexpr bool QREG = true;
  constexpr int NQF = QREG ? NSTEP : 1;
  h8 qf[NQF];
  const f16* qrow = Qg + (size_t)(wid * 32 + r32) * ldq + hi * 8;
  if (QREG) {
#pragma unroll
    for (int s = 0; s < NQF; ++s) qf[s] = *(const h8*)(qrow + s * 16); }
  unsigned selmask = 0;
  if (MOBA && qb <= 3) selmask = (1u << qb) - 1u;
  if (MOBA && qb > 3) {
    for (int idx = tid; idx < qb * 128; idx += 512) kml[idx] = kmg[idx];
    __syncthreads();
    float gate[7];
#pragma unroll
    for (int j = 0; j < 7; ++j) {
      gate[j] = NEG;
      if (j < qb) {
        float a = 0.f;
#pragma unroll
        for (int s = 0; s < NSTEP; ++s) {
          const f32x4 k0 = *(const LAS f32x4*)(kml + j * 128 + s * 16 + hi * 8), k1 = *(const LAS f32x4*)(kml + j * 128 + s * 16 + hi * 8 + 4);
          a += (float)qf[s][0] * k0[0] + (float)qf[s][1] * k0[1] + (float)qf[s][2] * k0[2] + (float)qf[s][3] * k0[3]
             + (float)qf[s][4] * k1[0] + (float)qf[s][5] * k1[1] + (float)qf[s][6] * k1[2] + (float)qf[s][7] * k1[3];
        }
        a += __shfl_xor(a, 32);
        gate[j] = a;
      }
    }
    {
#pragma unroll
      for (int rnd = 0; rnd < 3; ++rnd) {
        float best = NEG; int bi = 0;
#pragma unroll
        for (int j = 0; j < 7; ++j) { const bool ok = (j < qb) && !((selmask >> j) & 1u) && (gate[j] > best); if (ok) { best = gate[j]; bi = j; } }
        selmask |= 1u << bi;
      }
    }
  }
  const int NT = MOBA ? 4 * (qb + 1) : 4;
  const LAS unsigned char* kb0 = Kl + r32 * KS + hi * 16;
  const LAS unsigned char* vb0 = Vl + (((lane & 15) >> 2) + 4 * hi) * VS + (16 * ((lane >> 4) & 1) + 4 * (lane & 3)) * 2;
#pragma unroll 1
  for (int pass = 0; pass < NPASS; ++pass) {
    f32x16 o[4];
#pragma unroll
    for (int d = 0; d < 4; ++d)
#pragma unroll
      for (int r = 0; r < 16; ++r) o[d][r] = 0.f;
    float m_run = NEG, l_run = 0.f;
    u32x4 kreg[KPT], vreg[VPT];
#define ATT_KEY0(t) (MOBA ? (((t) < 4 ? qb : (((t) - 4) >> 2)) * 256 + ((t) & 3) * 64) : (t) * 64)
#define ATT_LOAD(t) do { const int key0_ = ATT_KEY0(t); int tid_ = tid; asm volatile("" : "+v"(tid_)); \
      _Pragma("unroll") for (int i = 0; i < KPT; ++i) { const int id = tid_ + 512 * i, row = id / KCH, ch = id % KCH; kreg[i] = *(const u32x4*)(Kg + (size_t)(key0_ + row) * ldkv + ch * 8); } \
      _Pragma("unroll") for (int i = 0; i < VPT; ++i) { const int id = tid_ + 512 * i, row = id >> 4, ch = id & 15; vreg[i] = *(const u32x4*)(Vg + pass * 128 + (size_t)(key0_ + row) * ldkv + ch * 8); } } while (0)
#define ATT_STORE(bo) do { \
      _Pragma("unroll") for (int i = 0; i < KPT; ++i) { const int id = tid + 512 * i, row = id / KCH, ch = id % KCH; *(LAS u32x4*)(Kl + (bo) + row * KS + ch * 16) = kreg[i]; } \
      _Pragma("unroll") for (int i = 0; i < VPT; ++i) { const int id = tid + 512 * i, row = id >> 4, ch = id & 15; *(LAS u32x4*)(Vl + (bo) + row * VS + ch * 16) = vreg[i]; } } while (0)
    ATT_LOAD(0);
    ATT_STORE(0);
    if (NT > 1) ATT_LOAD(1);
    __syncthreads();
#define ATT_TILE(OWN_) do { \
      const int bo = (t & 1) * BUFB; \
      const LAS unsigned char* kb = kb0 + bo; const LAS unsigned char* vb = vb0 + bo; \
      const int blk = MOBA ? (OWN_ ? qb : ((t - 4) >> 2)) : 0, kt = t & 3; \
      const bool own = MOBA && OWN_; \
      const bool sel = own || !MOBA || (((selmask >> blk) & 1u) != 0u); \
      bool need = true; \
      if (MOBA) { if (own) need = (kt <= (wid >> 1)); else need = (__ballot((selmask >> blk) & 1u) != 0ull); } \
      if (need) { \
        f32x16 p0, p1; \
        const f32x16 zero16 = {0.f, 0.f, 0.f, 0.f, 0.f, 0.f, 0.f, 0.f, 0.f, 0.f, 0.f, 0.f, 0.f, 0.f, 0.f, 0.f}; \
        const f16* qr = qrow; if (!QREG) asm volatile("" : "+v"(qr)); \
      _Pragma("unroll") \
        for (int s = 0; s < NSTEP; ++s) { \
          const h8 k0 = *(const LAS h8*)(kb + s * 32), k1 = *(const LAS h8*)(kb + 32 * KS + s * 32); \
          const h8 q = QREG ? qf[QREG ? s : 0] : *(const h8*)(qr + s * 16); \
          p0 = __builtin_amdgcn_mfma_f32_32x32x16_f16(k0, q, s == 0 ? zero16 : p0, 0, 0, 0); \
          p1 = __builtin_amdgcn_mfma_f32_32x32x16_f16(k1, q, s == 0 ? zero16 : p1, 0, 0, 0); \
        } \
        if (MOBA && own) { \
          const int qpos = wid * 32 + r32, kbase = kt * 64 + 4 * hi; \
      _Pragma("unroll") \
          for (int r = 0; r < 16; ++r) { const int kv = kbase + (r & 3) + 8 * (r >> 2); if (kv > qpos) p0[r] = NEG; if (kv + 32 > qpos) p1[r] = NEG; } \
        } \
        float mx = fmaxf(p0[0], p1[0]); \
      _Pragma("unroll") \
        for (int r = 1; r < 16; ++r) mx = fmaxf(mx, fmaxf(p0[r], p1[r])); \
        mx = fmaxf(mx, __shfl_xor(mx, 32)); \
        if (!sel) mx = NEG; \
        const float m_new = fmaxf(m_run, mx); \
        const float alpha = __builtin_amdgcn_exp2f(m_run - m_new); \
        m_run = m_new; \
        float ps = 0.f; \
        const float m_sub = sel ? m_new : INFINITY; \
      _Pragma("unroll") \
        for (int r = 0; r < 16; ++r) { p0[r] = __builtin_amdgcn_exp2f(p0[r] - m_sub); p1[r] = __builtin_amdgcn_exp2f(p1[r] - m_sub); ps += p0[r] + p1[r]; } \
        l_run = l_run * alpha + ps; \
        if (__ballot(alpha != 1.0f) != 0ull) { \
      _Pragma("unroll") \
          for (int d = 0; d < 4; ++d) \
      _Pragma("unroll") \
            for (int r = 0; r < 16; ++r) o[d][r] *= alpha; \
        } \
        h8 pf[4]; \
        { u32x4 w; \
          w.x = pk_f16(p0[0], p0[1]); w.y = pk_f16(p0[2], p0[3]); w.z = pk_f16(p0[4], p0[5]); w.w = pk_f16(p0[6], p0[7]); pf[0] = __builtin_bit_cast(h8, w); \
          w.x = pk_f16(p0[8], p0[9]); w.y = pk_f16(p0[10], p0[11]); w.z = pk_f16(p0[12], p0[13]); w.w = pk_f16(p0[14], p0[15]); pf[1] = __builtin_bit_cast(h8, w); \
          w.x = pk_f16(p1[0], p1[1]); w.y = pk_f16(p1[2], p1[3]); w.z = pk_f16(p1[4], p1[5]); w.w = pk_f16(p1[6], p1[7]); pf[2] = __builtin_bit_cast(h8, w); \
          w.x = pk_f16(p1[8], p1[9]); w.y = pk_f16(p1[10], p1[11]); w.z = pk_f16(p1[12], p1[13]); w.w = pk_f16(p1[14], p1[15]); pf[3] = __builtin_bit_cast(h8, w); } \
      _Pragma("unroll") \
        for (int s = 0; s < 4; ++s) \
      _Pragma("unroll") \
          for (int d = 0; d < 4; ++d) { \
            const s16x4 lo = vtr(vb + (16 * s) * VS + d * 64), hh = vtr(vb + (16 * s + 8) * VS + d * 64); \
            typedef short s16x8 __attribute__((ext_vector_type(8))); \
            const s16x8 av = {lo[0], lo[1], lo[2], lo[3], hh[0], hh[1], hh[2], hh[3]}; \
            o[d] = __builtin_amdgcn_mfma_f32_32x32x16_f16(__builtin_bit_cast(h8, av), pf[s], o[d], 0, 0, 0); \
          } \
      } \
      if (t + 1 < NT) { ATT_STORE(BUFB - bo); if (t + 2 < NT) ATT_LOAD(t + 2); } \
      __syncthreads(); \
    } while (0)
    int t = 0;
#pragma unroll 1
    for (; t < NT && t < (MOBA ? 4 : NT); ++t) ATT_TILE(1);
#pragma unroll 1
    for (; t < NT; ++t) ATT_TILE(0);
#undef ATT_TILE
#undef ATT_LOAD
#undef ATT_STORE
#undef ATT_KEY0
    const float l = l_run + __shfl_xor(l_run, 32);
    const float inv = 1.0f / l;
    { LAS unsigned char* stg = lds + wid * 8192;
      int l1 = lane; asm volatile("" : "+v"(l1) :: "memory"); const int r1 = l1 & 31, h1 = l1 >> 5;
#pragma unroll
      for (int d = 0; d < 4; ++d)
#pragma unroll
        for (int rg = 0; rg < 4; ++rg) {
          u32x2 w; w.x = pk_f16(o[d][4 * rg] * inv, o[d][4 * rg + 1] * inv); w.y = pk_f16(o[d][4 * rg + 2] * inv, o[d][4 * rg + 3] * inv);
          *(LAS u32x2*)(stg + r1 * 256 + (((4 * d + rg) ^ (r1 & 15)) << 4) + h1 * 8) = w;
        }
      int l2 = lane; asm volatile("" : "+v"(l2) :: "memory");
      const int c2 = l2 & 15, h2 = l2 >> 4;
      f16* obase = Og + (size_t)(wid * 32) * ldo + pass * 128 + c2 * 8;
#pragma unroll
      for (int i = 0; i < 8; ++i) {
        const int q = 4 * i + h2;
        const u32x4 v = *(const LAS u32x4*)(stg + q * 256 + ((c2 ^ (q & 15)) << 4));
        *(u32x4*)(obase + (size_t)q * ldo) = v;
      }
    }
    __syncthreads();
  }
}


__device__ __forceinline__ void xatt_unit(LAS unsigned char* lds, const f16* Qg, const f16* Kg, const f16* Vg, f16* Og, const int tid) {
  constexpr int KS = 528, VS = 576, TB = 64 * VS, LDKV = 2048;
  const int lane = tid & 63, wid = __builtin_amdgcn_readfirstlane(tid >> 6), r32 = lane & 31, hi = lane >> 5;
  h8 qf[16];
  { const f16* qrow = Qg + (size_t)(wid * 32 + r32) * DM + hi * 8;
#pragma unroll
    for (int s = 0; s < 16; ++s) qf[s] = *(const h8*)(qrow + s * 16); }
  u32x4 kreg[4];
#define XLOAD(t) do { int tid_ = tid; asm volatile("" : "+v"(tid_)); const f16* base_ = ((t) < 4) ? Kg + (size_t)((t) * 64) * LDKV : Vg + (size_t)(((t) - 4) * 64) * LDKV; \
    _Pragma("unroll") for (int i = 0; i < 4; ++i) { const int id = tid_ + 512 * i, row = id >> 5, ch = id & 31; kreg[i] = *(const u32x4*)(base_ + (size_t)row * LDKV + ch * 8); } } while (0)
#define XSTORE(t, bo) do { int tid_ = tid; asm volatile("" : "+v"(tid_)); const int st_ = ((t) < 4) ? KS : VS; \
    _Pragma("unroll") for (int i = 0; i < 4; ++i) { const int id = tid_ + 512 * i, row = id >> 5, ch = id & 31; *(LAS u32x4*)(lds + (bo) + row * st_ + ch * 16) = kreg[i]; } } while (0)
  XLOAD(0); XSTORE(0, 0); XLOAD(1);
  __syncthreads();
  f32x16 p[8];
#pragma unroll
  for (int j = 0; j < 8; ++j)
#pragma unroll
    for (int r = 0; r < 16; ++r) p[j][r] = 0.f;
#pragma unroll
  for (int t = 0; t < 4; ++t) {
    const int bo = (t & 1) * TB;
    const LAS unsigned char* kb = lds + bo + r32 * KS + hi * 16;
#pragma unroll
    for (int s = 0; s < 16; ++s) {
      const h8 k0 = *(const LAS h8*)(kb + s * 32), k1 = *(const LAS h8*)(kb + 32 * KS + s * 32);
      p[2 * t] = __builtin_amdgcn_mfma_f32_32x32x16_f16(k0, qf[s], p[2 * t], 0, 0, 0);
      p[2 * t + 1] = __builtin_amdgcn_mfma_f32_32x32x16_f16(k1, qf[s], p[2 * t + 1], 0, 0, 0);
    }
    XSTORE(t + 1, TB - bo); XLOAD(t + 2);
    __syncthreads();
  }
  float mx = p[0][0];
#pragma unroll
  for (int j = 0; j < 8; ++j)
#pragma unroll
    for (int r = 0; r < 16; ++r) mx = fmaxf(mx, p[j][r]);
  mx = fmaxf(mx, __shfl_xor(mx, 32));
  float l = 0.f;
  h8 pf[16];
#pragma unroll
  for (int j = 0; j < 8; ++j) {
#pragma unroll
    for (int r = 0; r < 16; ++r) { p[j][r] = __builtin_amdgcn_exp2f(p[j][r] - mx); l += p[j][r]; }
    u32x4 w;
    w.x = pk_f16(p[j][0], p[j][1]); w.y = pk_f16(p[j][2], p[j][3]); w.z = pk_f16(p[j][4], p[j][5]); w.w = pk_f16(p[j][6], p[j][7]); pf[2 * j] = __builtin_bit_cast(h8, w);
    w.x = pk_f16(p[j][8], p[j][9]); w.y = pk_f16(p[j][10], p[j][11]); w.z = pk_f16(p[j][12], p[j][13]); w.w = pk_f16(p[j][14], p[j][15]); pf[2 * j + 1] = __builtin_bit_cast(h8, w);
  }
  l += __shfl_xor(l, 32);
  const float inv = 1.0f / l;
  f32x16 o[8];
#pragma unroll
  for (int d = 0; d < 8; ++d)
#pragma unroll
    for (int r = 0; r < 16; ++r) o[d][r] = 0.f;
#pragma unroll
  for (int t = 4; t < 8; ++t) {
    const int bo = (t & 1) * TB;
    const LAS unsigned char* vb = lds + bo + (((lane & 15) >> 2) + 4 * hi) * VS + (16 * ((lane >> 4) & 1) + 4 * (lane & 3)) * 2;
#pragma unroll
    for (int s = 0; s < 4; ++s)
#pragma unroll
      for (int d = 0; d < 8; ++d) {
        const s16x4 lo = vtr(vb + (16 * s) * VS + d * 64), hh = vtr(vb + (16 * s + 8) * VS + d * 64);
        typedef short s16x8 __attribute__((ext_vector_type(8)));
        const s16x8 av = {lo[0], lo[1], lo[2], lo[3], hh[0], hh[1], hh[2], hh[3]};
        o[d] = __builtin_amdgcn_mfma_f32_32x32x16_f16(__builtin_bit_cast(h8, av), pf[4 * (t - 4) + s], o[d], 0, 0, 0);
      }
    if (t + 1 < 8) XSTORE(t + 1, TB - bo);
    if (t + 2 < 8) XLOAD(t + 2);
    __syncthreads();
  }
#undef XLOAD
#undef XSTORE
  { LAS unsigned char* stg = lds + wid * 16384; int l1 = lane; asm volatile("" : "+v"(l1) :: "memory"); const int r1 = l1 & 31, h1 = l1 >> 5;
#pragma unroll
    for (int d = 0; d < 8; ++d) {
      asm volatile("" ::: "memory");
#pragma unroll
      for (int rg = 0; rg < 4; ++rg) {
        u32x2 w; w.x = pk_f16(o[d][4 * rg] * inv, o[d][4 * rg + 1] * inv); w.y = pk_f16(o[d][4 * rg + 2] * inv, o[d][4 * rg + 3] * inv);
        *(LAS u32x2*)(stg + r1 * 512 + (((4 * d + rg) ^ r1) << 4) + h1 * 8) = w;
      }
    }
    int l2 = lane; asm volatile("" : "+v"(l2) :: "memory");
    const int c2 = l2 & 31, h2 = l2 >> 5;
    f16* obase = Og + (size_t)(wid * 32) * DM + c2 * 8;
#pragma unroll
    for (int i = 0; i < 16; ++i) {
      const int q = 2 * i + h2;
      const u32x4 v = *(const LAS u32x4*)(stg + q * 512 + ((c2 ^ q) << 4));
      *(u32x4*)(obase + (size_t)q * DM) = v;
    }
  }
  __syncthreads();
}

#define XB_TMO      128
#define XB_XCNT(j)  (256  + 64 * (j))
#define XB_XSUB(j)  (1280 + 64 * (j))
#define XB_XGEN(j)  (2304 + 64 * (j))
#define XB_TOP      3328
#define XB_TOPGEN   3392
#define XCD_BAR_WORDS 3456
#define XB_SPIN_CAP (1u << 22)
__device__ __forceinline__ unsigned xb_ld(unsigned* p)              { return __hip_atomic_load(p, __ATOMIC_RELAXED, __HIP_MEMORY_SCOPE_AGENT); }
__device__ __forceinline__ unsigned xb_add(unsigned* p, unsigned v) { return __hip_atomic_fetch_add(p, v, __ATOMIC_RELAXED, __HIP_MEMORY_SCOPE_AGENT); }
__device__ __forceinline__ unsigned xb_xcc_id() { return (unsigned)__builtin_amdgcn_s_getreg((3 << 11) | 20) & 0xFu; }
#define XB_SPIN(cond, bar) do { unsigned _sp = 0; while (cond) { __builtin_amdgcn_s_sleep(1); \
    if ((++_sp & 255u) == 0u) { if (xb_ld(&(bar)[XB_TMO])) break; if (_sp > XB_SPIN_CAP) { atomicAdd(&(bar)[XB_TMO], 1u); break; } } } } while (0)
struct XcdBarrier { unsigned* bar; unsigned x; volatile LAS unsigned* st; };
__device__ __forceinline__ XcdBarrier xcd_barrier_post(unsigned* bar, volatile LAS unsigned* st) {
  XcdBarrier b; b.bar = bar; b.x = xb_xcc_id(); b.st = st;
  if (threadIdx.x == 0) (void)xb_add(&bar[XB_XCNT(b.x)], 1u);
  return b;
}
__device__ __forceinline__ void xcd_barrier_complete(unsigned* bar, unsigned x, unsigned& nloc, unsigned& nx) {
  const unsigned G = gridDim.x * gridDim.y * gridDim.z;
  unsigned sum, cnt, mine, sp = 0u;
  for (;;) {
    sum = 0u; cnt = 0u; mine = 0u;
#pragma unroll
    for (unsigned j = 0; j < 16; ++j) { const unsigned c = xb_ld(&bar[XB_XCNT(j)]); sum += c; cnt += (c > 0u) ? 1u : 0u; }
    mine = xb_ld(&bar[XB_XCNT(x)]);
    if (sum == G) break;
    __builtin_amdgcn_s_sleep(1);
    if ((++sp & 255u) == 0u) { if (xb_ld(&bar[XB_TMO])) break; if (sp > XB_SPIN_CAP) { atomicAdd(&bar[XB_TMO], 1u); break; } }
  }
  nloc = mine > 0u ? mine : 1u; nx = cnt > 0u ? cnt : 1u;
}
__device__ __forceinline__ void xcd_barrier(const XcdBarrier& b) {
  asm volatile("s_waitcnt vmcnt(0)" ::: "memory");
  __syncthreads();
  if (threadIdx.x == 0) {
    unsigned* bar = b.bar;
    unsigned nloc = b.st[0], nx = b.st[1];
    if (nloc == 0u) { xcd_barrier_complete(bar, b.x, nloc, nx); b.st[0] = nloc; b.st[1] = nx; }
    const unsigned k = b.st[2]; b.st[2] = k + 1u;
    const unsigned old = xb_add(&bar[XB_XSUB(b.x)], 1u);
    if (old + 1u == (k + 1u) * nloc) {
      __builtin_amdgcn_fence(__ATOMIC_RELEASE, "agent");
      asm volatile("s_waitcnt vmcnt(0)" ::: "memory");
      (void)xb_add(&bar[XB_TOP], 1u);
    }
    const unsigned target = (k + 1u) * nx;
    XB_SPIN(xb_ld(&bar[XB_TOP]) < target, bar);
    __builtin_amdgcn_fence(__ATOMIC_ACQUIRE, "agent");
    asm volatile("s_waitcnt vmcnt(0)" ::: "memory");
  }
  __syncthreads();
}

__device__ __forceinline__ void ew_phase(int vcu, int G, int wave, int lane, const float* xin, float* X, f16* R1, const float* gpost, const float* gpre) {
  f32x4 gp[4], gq[4];
#pragma unroll
  for (int j = 0; j < 4; ++j) { gp[j] = gpost ? *(const f32x4*)(gpost + lane * 4 + 256 * j) : (f32x4){0.f, 0.f, 0.f, 0.f}; gq[j] = gpre ? *(const f32x4*)(gpre + lane * 4 + 256 * j) : (f32x4){0.f, 0.f, 0.f, 0.f}; }
#pragma unroll 1
  for (int m = vcu * 8 + wave; m < M; m += G * 8) {
    const float* xr = (xin ? xin : X) + (size_t)m * DM + lane * 4;
    f16* rr = R1 + (size_t)m * DM + lane * 4;
    f32x4 xv[4];
#pragma unroll
    for (int j = 0; j < 4; ++j) xv[j] = *(const f32x4*)(xr + 256 * j);
    if (gpost) {
      f32x4 yv[4]; float ss = 0.f;
#pragma unroll
      for (int j = 0; j < 4; ++j) { const h4 y = *(const h4*)(rr + 256 * j); yv[j] = (f32x4){(float)y[0], (float)y[1], (float)y[2], (float)y[3]}; ss += yv[j][0] * yv[j][0] + yv[j][1] * yv[j][1] + yv[j][2] * yv[j][2] + yv[j][3] * yv[j][3]; }
      const float rstd = 1.0f / sqrtf(wave_sum(ss) * (1.0f / DM) + RMS_EPS);
#pragma unroll
      for (int j = 0; j < 4; ++j) xv[j] = xv[j] + yv[j] * rstd * gp[j];
    }
    float* xo = X + (size_t)m * DM + lane * 4;
#pragma unroll
    for (int j = 0; j < 4; ++j) *(f32x4*)(xo + 256 * j) = xv[j];
    if (gpre) {
      float ss = 0.f;
#pragma unroll
      for (int j = 0; j < 4; ++j) ss += xv[j][0] * xv[j][0] + xv[j][1] * xv[j][1] + xv[j][2] * xv[j][2] + xv[j][3] * xv[j][3];
      const float rstd = 1.0f / sqrtf(wave_sum(ss) * (1.0f / DM) + RMS_EPS);
#pragma unroll
      for (int j = 0; j < 4; ++j) { const f32x4 h = xv[j] * rstd * gq[j]; u32x2 w; w.x = pk_f16(h[0], h[1]); w.y = pk_f16(h[2], h[3]); *(u32x2*)(rr + 256 * j) = w; }
    }
  }
}

__device__ __forceinline__ void pool_phase(int vcu, int G, const f16* U, f16* P, const int tid, int tile_pm, int tile_pn) {
  const int id0 = tile_pm >= 0 ? ((tile_pm * 16 + (tid >> 5)) << 7) + tile_pn * 32 + (tid & 31) : vcu * 512 + tid;
  const int idstep = tile_pm >= 0 ? (M / 16) * 128 : G * 512;
#pragma unroll 1
  for (int id = id0; id < (M / 16) * 128; id += idstep) {
    const int chunk = id & 127, run = id >> 7, grp = chunk >> 5, w = 2 << grp;
    const int row0 = run * 16, t0 = row0 & (SEQ - 1);
    const f16* up = U + (size_t)row0 * DM + chunk * 8;
    f16* pp = P + (size_t)row0 * DM + chunk * 8;
    float sum[8];
#pragma unroll
    for (int e = 0; e < 8; ++e) sum[e] = 0.f;
    for (int k = 1; k < w; ++k) {
      if (t0 - k >= 0) { const h8 v = *(const h8*)(up - (size_t)k * DM);
#pragma unroll
        for (int e = 0; e < 8; ++e) sum[e] += (float)v[e]; }
    }
    for (int i = 0; i < 16; ++i) {
      const int t = t0 + i;
      const h8 cur = *(const h8*)(up + (size_t)i * DM);
      const float rc = 1.0f / (float)(t + 1 < w ? t + 1 : w);
      float o[8];
#pragma unroll
      for (int e = 0; e < 8; ++e) { sum[e] += (float)cur[e]; o[e] = sum[e] * rc - (float)cur[e]; }
      u32x4 wv; wv.x = pk_f16(o[0], o[1]); wv.y = pk_f16(o[2], o[3]); wv.z = pk_f16(o[4], o[5]); wv.w = pk_f16(o[6], o[7]);
      *(u32x4*)(pp + (size_t)i * DM) = wv;
      if (t - w + 1 >= 0) { const h8 old = *(const h8*)(up + (size_t)(i - w + 1) * DM);
#pragma unroll
        for (int e = 0; e < 8; ++e) sum[e] -= (float)old[e]; }
    }
  }
}

__device__ __forceinline__ void conv_matrix(const float* W, int K, int N, f16* WT, int ldk, int& off, int gw, int NGW, int lane, LAS unsigned char* stg) {
  const int nblk = N / 64, nitems = (K / 64) * nblk;
  int first = gw - (off % NGW); if (first < 0) first += NGW;
#pragma unroll 1
  for (int item = first; item < nitems; item += NGW) {
    const int kb = item / nblk, nb = item % nblk, k0 = 64 * kb, n0 = 64 * nb;
    const float* src = W + (size_t)k0 * N + n0 + lane;
    float v[64];
#pragma unroll
    for (int j = 0; j < 64; ++j) v[j] = __builtin_nontemporal_load(src + (size_t)j * N);
#pragma unroll
    for (int q = 0; q < 8; ++q) { u32x4 o; o.x = pk_f16(v[8 * q], v[8 * q + 1]); o.y = pk_f16(v[8 * q + 2], v[8 * q + 3]); o.z = pk_f16(v[8 * q + 4], v[8 * q + 5]); o.w = pk_f16(v[8 * q + 6], v[8 * q + 7]);
      *(LAS u32x4*)(stg + lane * 144 + q * 16) = o; }
    asm volatile("s_waitcnt lgkmcnt(0)" ::: "memory");
    f16* dst = WT + (size_t)(n0 + (lane >> 3)) * ldk + k0 + (lane & 7) * 8;
#pragma unroll
    for (int i = 0; i < 8; ++i) {
      const u32x4 o = *(const LAS u32x4*)(stg + (8 * i + (lane >> 3)) * 144 + (lane & 7) * 16);
      *(u32x4*)(dst + (size_t)(8 * i) * ldk) = o;
    }
    asm volatile("s_waitcnt lgkmcnt(0)" ::: "memory");
  }
  off += nitems;
}

__device__ const double INV_FREQ[16] = {
  1.0, 0.44036660267178046, 0.19392274474868576, 0.08539710028576561, 0.03760603093086393, 0.016560440080994446,
  0.007292664737217109, 0.003211445994752591, 0.001414213562373095, 0.000622772421914596, 0.0002742481756762073,
  0.00012076973741146504, 5.318295896944988e-05, 2.341999896140934e-05, 1.031338537721246e-05, 4.5416704806078695e-06 };

struct Args { const float* in[14]; float* out; unsigned char* ws; int ph_lo, ph_hi; };

__device__ __forceinline__ void conv_layer(const Args& a, int i, int& scr, int gw, int NGW, int lane, LAS unsigned char* stg) {
  unsigned char* wb = a.ws + WS_W; const int j = i >> 1;
  if ((i & 1) == 0) {
    conv_matrix(a.in[4] + (size_t)j * DM * DM, DM, DM, (f16*)(wb + WP_IN), DM, scr, gw, NGW, lane, stg);
    for (int g = 0; g < 4; ++g) conv_matrix(a.in[5] + (size_t)(j * 4 + g) * 65536, 256, 256, (f16*)(wb + WP_GRP) + g * 65536, 256, scr, gw, NGW, lane, stg);
    conv_matrix(a.in[9] + (size_t)i * DM * DM, DM, DM, (f16*)(wb + WP_XQ), DM, scr, gw, NGW, lane, stg);
    conv_matrix(a.in[11] + (size_t)i * DM * DM, DM, DM, (f16*)(wb + WP_XO), DM, scr, gw, NGW, lane, stg);
    conv_matrix(a.in[12] + (size_t)i * DM * DFF, DM, DFF, (f16*)(wb + WP_W1), DM, scr, gw, NGW, lane, stg);
    conv_matrix(a.in[13] + (size_t)i * DFF * DM, DFF, DM, (f16*)(wb + WP_W2), DFF, scr, gw, NGW, lane, stg);
  } else {
    conv_matrix(a.in[7] + (size_t)j * DM * 3 * DM, DM, 3 * DM, (f16*)(wb + WM_QKV), DM, scr, gw, NGW, lane, stg);
    conv_matrix(a.in[8] + (size_t)j * DM * DM, DM, DM, (f16*)(wb + WM_O), DM, scr, gw, NGW, lane, stg);
    conv_matrix(a.in[9] + (size_t)i * DM * DM, DM, DM, (f16*)(wb + WM_XQ), DM, scr, gw, NGW, lane, stg);
    conv_matrix(a.in[11] + (size_t)i * DM * DM, DM, DM, (f16*)(wb + WM_XO), DM, scr, gw, NGW, lane, stg);
    conv_matrix(a.in[12] + (size_t)i * DM * DFF, DM, DFF, (f16*)(wb + WM_W1), DM, scr, gw, NGW, lane, stg);
    conv_matrix(a.in[13] + (size_t)i * DFF * DM, DFF, DM, (f16*)(wb + WM_W2), DFF, scr, gw, NGW, lane, stg);
  }
}

constexpr int NPHASE = 2 + 11 * DEPTH;

__global__ void __launch_bounds__(512, 2) mega_fwd(Args a) {
  extern __shared__ __attribute__((aligned(16))) unsigned char lds_raw[];
  LAS unsigned char* lds = (LAS unsigned char*)lds_raw;
  const int G = gridDim.x, bx = blockIdx.x;
  const int vcu = (G % 8 == 0) ? (bx % 8) * (G / 8) + bx / 8 : bx;
  const int NGW = G * 8;

  volatile LAS unsigned* MISC = (volatile LAS unsigned*)(lds + 131072);
  if (threadIdx.x < 16) MISC[threadIdx.x] = 0u;
  __syncthreads();
  const XcdBarrier xbar = xcd_barrier_post((unsigned*)(a.ws + WS_BAR), MISC + 8);
  int nrun = 0;
#if TPROBE
  unsigned long long tacc = 0ull, t_end = __builtin_amdgcn_s_memrealtime();
#endif
#pragma unroll 1
  for (int ph = a.ph_lo; ph < a.ph_hi; ++ph) {
    unsigned long long wsi = (unsigned long long)a.ws; asm volatile("" : "+s"(wsi));
    unsigned char* ws = (unsigned char*)(__attribute__((address_space(1))) unsigned char*)wsi;
    float* X = a.out;
    f16* R1 = (f16*)(ws + WS_R1);
    f16* BIG = (f16*)(ws + WS_BIG);
    f16* KVM = (f16*)(ws + WS_KVM);
    float* KMEAN = (float*)(ws + WS_KMEAN);
    float* ROPE = (float*)(ws + WS_ROPE);
    const float* gains = a.in[2];
    int tid = threadIdx.x; asm volatile("" : "+v"(tid));
    const int lane = tid & 63, wave = __builtin_amdgcn_readfirstlane(tid >> 6), gw = vcu * 8 + wave;
    int scr = 0;
    LAS unsigned char* stg = lds + wave * 9216;
    enum { K_NONE, K_GEMM, K_EW, K_POOL, K_MOBA, K_XATT, K_PRO, K_CONV };
    int kind = K_NONE;
    GemmDesc g; g.A = nullptr; g.Bt = nullptr; g.lda = DM; g.ldb = DM; g.K = DM; g.nM = M / BM; g.nN = 4; g.mode = GM_NORMAL;
    g.epi = EPI_F16; g.act = 0; g.O = nullptr; g.ldc = DM; g.colscale = nullptr; g.cscale = 1.f; g.rope = ROPE; g.kmean = KMEAN;
    g.fuse = 0; g.want = 0; g.g1 = nullptr; g.g2 = nullptr; g.X = X; g.xslot = (float*)(ws + WS_XSLOT); g.xcnt = (unsigned*)(ws + WS_XCNT);
    const bool fuse = (G == 256);
    const float* ew_post = nullptr; const float* ew_pre = nullptr; int li = 0; bool conv23 = false; bool nobar = false;
    if (ph == 0) kind = K_PRO;
    else if (ph == 1) {
      kind = K_GEMM; g.A = BIG; g.Bt = BIG + 8 * MiB; g.nM = 32; g.nN = 8; g.mode = GM_KVM; g.O = KVM; g.ldc = 2048;
    } else {
      li = (ph - 2) / 11; const int s = (ph - 2) % 11; const bool moba = (li & 1) != 0;
      const f16* wl = (const f16*)(ws + WS_W);
      const float* gl = gains + (size_t)li * 6 * DM;
      switch (s) {
        case 0:
          kind = K_GEMM; g.A = R1;
          if (!moba) { g.Bt = wl + WP_IN / 2; g.O = BIG; }
          else { g.Bt = wl + WM_QKV / 2; g.nN = 12; g.O = BIG; g.ldc = 3 * DM; g.epi = EPI_QKV; g.cscale = 0.08838834764831845f * LOG2E; g.kmean = KMEAN + (size_t)(li >> 1) * 65536; }
          break;
        case 1: kind = moba ? K_MOBA : K_POOL; break;
        case 2:
          kind = K_GEMM; g.O = R1;
          if (!moba) { g.A = BIG + 16 * MiB; g.Bt = wl + WP_GRP / 2; g.ldb = 256; g.K = 256; g.mode = GM_GROUPED; g.colscale = a.in[6] + (size_t)(li >> 1) * DM; nobar = fuse; }
          else { g.A = BIG + 48 * MiB; g.Bt = wl + WM_O / 2; }
          if (fuse) { g.fuse = 1; g.g1 = gl + 1 * DM; g.g2 = gl + 2 * DM; g.want = 32u * (unsigned)(li * 3 + 1); }
          break;
        case 3: kind = fuse ? K_NONE : K_EW; ew_post = gl + 1 * DM; ew_pre = gl + 2 * DM; break;
        case 4: kind = K_GEMM; g.A = R1; g.Bt = wl + (moba ? WM_XQ : WP_XQ) / 2; g.O = BIG; g.cscale = 0.0625f * LOG2E; break;
        case 5: kind = K_XATT; nobar = fuse; break;
        case 6: kind = K_GEMM; g.A = BIG + 16 * MiB; g.Bt = wl + (moba ? WM_XO : WP_XO) / 2; g.O = R1;
          if (fuse) { g.fuse = 1; g.g1 = gl + 3 * DM; g.g2 = gl + 4 * DM; g.want = 32u * (unsigned)(li * 3 + 2); }
          break;
        case 7: kind = fuse ? K_NONE : K_EW; ew_post = gl + 3 * DM; ew_pre = gl + 4 * DM; break;
        case 8: kind = K_GEMM; g.A = R1; g.Bt = wl + (moba ? WM_W1 : WP_W1) / 2; g.nN = 16; g.O = BIG; g.ldc = DFF; g.act = 1; break;
        case 9: kind = K_GEMM; g.A = BIG; g.lda = DFF; g.Bt = wl + (moba ? WM_W2 : WP_W2) / 2; g.ldb = DFF; g.K = DFF; g.O = R1;
          if (fuse) { g.fuse = 1; g.g1 = gl + 5 * DM; g.g2 = (li + 1 < DEPTH) ? gl + 6 * DM : nullptr; g.want = 32u * (unsigned)(li * 3 + 3); }
          break;
        default: conv23 = (li == 1); kind = fuse ? (conv23 ? K_CONV : K_NONE) : K_EW; ew_post = gl + 5 * DM; ew_pre = (li + 1 < DEPTH) ? gl + 6 * DM : nullptr; break;
      }
    }

    if (kind == K_NONE) continue;
    if (nrun > 0) {
      if (a.ph_lo < 0) cg::this_grid().sync();
      if (nobar) { asm volatile("s_waitcnt vmcnt(0)" ::: "memory"); __syncthreads(); }
      else { xcd_barrier(xbar);
#if PROBE == 3
        xcd_barrier(xbar); xcd_barrier(xbar);
#endif
      }
    }
    ++nrun;
#if TPROBE
    const unsigned long long t0 = __builtin_amdgcn_s_memrealtime();
    if (TPROBE == 1) tacc += t0 - t_end;
#endif
    if (kind == K_GEMM) {
#if PROBE == 1
#pragma unroll 1
      for (int rep = 0; rep < 2; ++rep) { gemm_phase(lds, g, G, bx, tid); __syncthreads(); g.kmean = nullptr; }
#else
      gemm_phase(lds, g, G, bx, tid);
#endif
    } else if (kind == K_EW) {
      ew_phase(vcu, G, wave, lane, nullptr, X, R1, ew_post, ew_pre);
#if PROBE == 4
      if (ew_pre) { __syncthreads(); ew_phase(vcu, G, wave, lane, nullptr, X, R1, nullptr, ew_pre); }
#endif
#if PROBE == 5
      for (int rep = 0; rep < 2; ++rep)
#endif
      if (conv23) { conv_layer(a, 2, scr, gw, NGW, lane, stg); conv_layer(a, 3, scr, gw, NGW, lane, stg); }
    } else if (kind == K_CONV) {
      conv_layer(a, 2, scr, gw, NGW, lane, stg); conv_layer(a, 3, scr, gw, NGW, lane, stg);
    } else if (kind == K_POOL) {
#if PROBE == 6
      for (int rep = 0; rep < 2; ++rep)
#endif
      { int tpm = -1, tpn = 0; if (fuse) { Unit up; (void)sched_next(g, G, bx, 0, up); tpm = up.pm; tpn = up.pn; }
        pool_phase(vcu, G, BIG, BIG + 16 * MiB, tid, tpm, tpn); }
    } else if (kind == K_MOBA) {
      const float* km = KMEAN + (size_t)(li >> 1) * 65536;
#if PROBE == 2
      for (int rep = 0; rep < 2; ++rep)
#endif
      for (int uid = vcu; uid < 512; uid += G) {
        const int bh = (uid & 255) >> 2, qb = (uid < 256) ? 7 - (uid & 3) : (uid & 3), b = bh >> 3, h = bh & 7;
        const f16* base = BIG + (size_t)b * SEQ * 3 * DM + h * 128;
        attn_unit<128, true>(lds, base + (size_t)qb * 256 * 3 * DM, 3 * DM, base + DM, base + 2 * DM, 3 * DM,
                             BIG + 48 * MiB + (size_t)(b * SEQ + qb * 256) * DM + h * 128, DM, qb, km + (size_t)bh * 8 * 128, tid);
      }
    } else if (kind == K_XATT) {
#if PROBE == 2
      for (int rep = 0; rep < 2; ++rep)
#endif
      for (int uid = vcu; uid < 256; uid += G) {
        int b = uid >> 5, h = (uid >> 3) & 3, qt = uid & 7;
        if (fuse) { Unit u; (void)sched_next(g, G, bx, 0, u); b = u.pm >> 3; qt = u.pm & 7; h = u.pn; }
        const f16* kv = KVM + (size_t)li * 2048 * 2048 + (size_t)b * NMEM * 2048 + h * 256;
        xatt_unit(lds, BIG + (size_t)(b * SEQ + qt * 256) * DM + h * 256, kv, kv + DM, BIG + 16 * MiB + (size_t)(b * SEQ + qt * 256) * DM + h * 256, tid);
      }
    } else if (kind == K_PRO) {
#if PROBE == 5
      for (int rep = 0; rep < 2; ++rep) {
#else
      {
#endif
      conv_layer(a, 0, scr, gw, NGW, lane, stg); conv_layer(a, 1, scr, gw, NGW, lane, stg);
      for (int i = 0; i < DEPTH; ++i) conv_matrix(a.in[10] + (size_t)i * DM * 2 * DM, DM, 2 * DM, BIG + 8 * MiB + (size_t)i * 2048 * DM, DM, scr, gw, NGW, lane, stg);
      }
#pragma unroll 1
      for (int r = gw; r < BATCH * NMEM; r += NGW) {
        const float* mr = a.in[1] + (size_t)r * DM + lane * 4; f32x4 v[4]; float ss = 0.f;
#pragma unroll
        for (int j = 0; j < 4; ++j) { v[j] = *(const f32x4*)(mr + 256 * j); ss += v[j][0] * v[j][0] + v[j][1] * v[j][1] + v[j][2] * v[j][2] + v[j][3] * v[j][3]; }
        const float rstd = 1.0f / sqrtf(wave_sum(ss) * (1.0f / DM) + RMS_EPS);
        for (int i = 0; i < DEPTH; ++i) {
          const float* gm = a.in[3] + (size_t)i * DM + lane * 4; f16* orow = BIG + ((size_t)i * 2048 + r) * DM + lane * 4;
#pragma unroll
          for (int j = 0; j < 4; ++j) { const f32x4 gg = *(const f32x4*)(gm + 256 * j); const f32x4 h = v[j] * rstd * gg; u32x2 w; w.x = pk_f16(h[0], h[1]); w.y = pk_f16(h[2], h[3]); *(u32x2*)(orow + 256 * j) = w; }
        }
      }
#pragma unroll 1
      for (int id = vcu * 512 + tid; id < SEQ * 16; id += G * 512) {
        const int pos = id >> 4, i = id & 15;
        const double rev = (double)pos * INV_FREQ[i] * 0.15915494309189535;
        const float fr = (float)(rev - (double)(long long)rev);
        ROPE[id] = __builtin_amdgcn_cosf(fr); ROPE[SEQ * 16 + id] = __builtin_amdgcn_sinf(fr); asm volatile("" : "+v"(id));
      }
      { float* xs = (float*)(ws + WS_XSLOT); for (int id = vcu * 512 + tid; id < 2 * M * 8; id += G * 512) { xs[id] = 0.f; asm volatile("" : "+v"(id)); } }
      for (int id = vcu * 512 + tid; id < 2 * 65536; id += G * 512) { KMEAN[id] = 0.f; asm volatile("" : "+v"(id)); }
      ew_phase(vcu, G, wave, lane, a.in[0], X, R1, nullptr, gains);
    }
    __syncthreads();
#if TPROBE
    { const unsigned long long t1 = __builtin_amdgcn_s_memrealtime(); t_end = t1;
      int cat = 5;
      if (kind == K_GEMM) { cat = 2; }
      else if (kind == K_MOBA) cat = 3; else if (kind == K_XATT) cat = 4;
      bool hit = (cat == TPROBE);
      if (kind == K_GEMM) {
        if (TPROBE == 6) hit = (g.K == DFF);
        if (TPROBE == 7) hit = (g.nN == 16);
        if (TPROBE == 8) hit = (g.nN == 12);
        if (TPROBE == 9) hit = (g.nN == 4 && g.K == DM && g.mode == GM_NORMAL);
        if (TPROBE == 10) hit = (g.mode == GM_GROUPED);
        if (TPROBE == 12) hit = (g.mode == GM_KVM);
      }
      if (TPROBE == 11) hit = (kind == K_PRO);
      if (TPROBE == 13) hit = (kind == K_CONV);
      if (TPROBE == 14) hit = (kind == K_POOL);
      if (hit) tacc += t1 - t0; }
#endif
  }
#if TPROBE
  if (bx == 0) { const unsigned long long ts = __builtin_amdgcn_s_memrealtime(); while (__builtin_amdgcn_s_memrealtime() - ts < 3ull * tacc) __builtin_amdgcn_s_sleep(8); }
#endif
}

extern "C" void kernel_launch(void* const* d_in, const int* in_sizes, int n_in, void* d_out, int out_size, void* d_ws, size_t ws_size, hipStream_t stream) {
  static int grid = 0;
  if (grid == 0) {
    int dev = 0, cus = 0, per_cu = 0;
    hipGetDevice(&dev);
    hipDeviceGetAttribute(&cus, hipDeviceAttributeMultiprocessorCount, dev);
    hipFuncSetAttribute((const void*)mega_fwd, hipFuncAttributeMaxDynamicSharedMemorySize, LDS_BYTES);
    hipOccupancyMaxActiveBlocksPerMultiprocessor(&per_cu, (const void*)mega_fwd, 512, LDS_BYTES);
    if (per_cu < 1) { fprintf(stderr, "occupancy query returned %d\n", per_cu); per_cu = 1; }
    (void)hipGetLastError();
    grid = cus;
    if (ws_size < WS_END) fprintf(stderr, "workspace too small: %zu\n", ws_size);
  }
  (void)hipMemsetAsync((char*)d_ws + WS_BAR, 0, 48 * 1024, stream);
  Args a{};
  for (int i = 0; i < 14; ++i) a.in[i] = (const float*)d_in[i];
  a.out = (float*)d_out; a.ws = (unsigned char*)d_ws;
#if MULTI_LAUNCH
  for (int ph = 0; ph < NPHASE; ++ph) { a.ph_lo = ph; a.ph_hi = ph + 1; hipLaunchKernelGGL(mega_fwd, dim3(grid), dim3(512), LDS_BYTES, stream, a); }
#else
  a.ph_lo = 0; a.ph_hi = NPHASE;
  void* args[] = {&a};
  hipError_t e = hipLaunchCooperativeKernel((const void*)mega_fwd, dim3(grid), dim3(512), args, LDS_BYTES, stream);
  if (e != hipSuccess) fprintf(stderr, "cooperative launch failed: %s (grid %d)\n", hipGetErrorString(e), grid);
#endif
}
```

```cpp
#include <hip/hip_runtime.h>
#include <hip/hip_cooperative_groups.h>
#include <cstdio>
#include <cstdint>
namespace cg = cooperative_groups;

#ifndef PROBE
#define PROBE 0
#endif
#ifndef TPROBE
#define TPROBE 0
#endif
#ifndef MULTI_LAUNCH
#define MULTI_LAUNCH 0
#endif

#define LAS __attribute__((address_space(3)))
typedef _Float16 f16;
typedef _Float16 h8 __attribute__((ext_vector_type(8)));
typedef _Float16 h4 __attribute__((ext_vector_type(4)));
typedef _Float16 h2 __attribute__((ext_vector_type(2)));
typedef short s16x4 __attribute__((ext_vector_type(4)));
typedef float f32x2 __attribute__((ext_vector_type(2)));
typedef float f32x4 __attribute__((ext_vector_type(4)));
typedef float f32x16 __attribute__((ext_vector_type(16)));
typedef unsigned u32x4 __attribute__((ext_vector_type(4)));
typedef unsigned u32x2 __attribute__((ext_vector_type(2)));

constexpr int DM = 1024, BATCH = 8, SEQ = 2048, DEPTH = 4, NMEM = 256, DFF = 4096;
constexpr int M = BATCH * SEQ;
constexpr float RMS_EPS = 1e-6f;
constexpr float LOG2E = 1.4426950408889634f;

constexpr size_t MiB = 1u << 20;
constexpr size_t WS_KMEAN = 0;
constexpr size_t WS_ROPE = 512 * 1024;
constexpr size_t WS_W = 1 * MiB;
constexpr size_t WS_KVM = 60 * MiB;
constexpr size_t WS_R1 = 92 * MiB;
constexpr size_t WS_BIG = 124 * MiB;
constexpr size_t WS_END = 252 * MiB;
constexpr size_t WP_IN = 0, WP_GRP = 2 * MiB, WP_XQ = 3 * MiB, WP_XO = 5 * MiB, WP_W1 = 7 * MiB, WP_W2 = 15 * MiB;
constexpr size_t WM_QKV = 23 * MiB, WM_O = 29 * MiB, WM_XQ = 31 * MiB, WM_XO = 33 * MiB, WM_W1 = 35 * MiB, WM_W2 = 43 * MiB;

constexpr int LDS_BYTES = 131072 + 64;
constexpr size_t WS_BAR = 800 * 1024;
constexpr size_t WS_XCNT = 816 * 1024;
constexpr size_t WS_XSLOT = 52 * MiB;

__device__ __forceinline__ unsigned pk_f16(float lo, float hi) { f32x2 v = {lo, hi}; h2 h = __builtin_convertvector(v, h2); return __builtin_bit_cast(unsigned, h); }
__device__ __forceinline__ float wave_sum(float v) {
#pragma unroll
  for (int o = 1; o < 64; o <<= 1) v += __shfl_xor(v, o);
  return v;
}

constexpr int BM = 256, BK = 64, HALF = 128, HTB = HALF * BK * 2, NXCD = 8, WGM = 4;
__device__ __forceinline__ int lds_byte(int r, int c) { const int st = (r >> 4) * 2 + (c >> 5), rr = r & 15, cc = c & 31, ob = rr * 64 + cc * 2; return st * 1024 + (ob ^ (((ob >> 9) & 1) << 5)); }
__device__ __forceinline__ void stage_rc(int b, int& R, int& C) { const int st = b / 1024, sb = b % 1024, swz = sb ^ (((sb >> 9) & 1) << 5); R = (st >> 1) * 16 + swz / 64; C = (st & 1) * 32 + (swz % 64) / 2; }
__device__ __forceinline__ int perm32(int rho) { const int n = rho >> 4, i = rho & 15; return 8 * (i >> 2) + 4 * n + (i & 3); }

struct Unit { int pm, pn; };
enum { EPI_F16 = 0, EPI_QKV = 1 };
enum { GM_NORMAL = 0, GM_GROUPED = 1, GM_KVM = 2 };
struct GemmDesc {
  const f16* A; const f16* Bt; int lda, ldb, K, nM, nN, mode;
  int epi, act; f16* O; int ldc; const float* colscale; float cscale;
  const float* rope; float* kmean;
  int fuse; unsigned want; const float* g1; const float* g2; float* X; float* xslot; unsigned* xcnt;
};

__device__ __forceinline__ bool sched_next(const GemmDesc& g, int G, int c, int i, Unit& u) {
  const int nM = g.nM, nN = g.nN, nwg = nM * nN;
  const long L = (long)i * G + c; if (L >= nwg) return false;
  int wgid = (int)L; { const int q = nwg / NXCD, r = nwg % NXCD, xcd = wgid % NXCD, off = wgid / NXCD; wgid = (xcd < r ? xcd * (q + 1) : r * (q + 1) + (xcd - r) * q) + off; }
  const int nig = WGM * nN, gid = wgid / nig, fm = gid * WGM, gsz = (nM - fm) < WGM ? (nM - fm) : WGM;
  u.pm = fm + ((wgid % nig) % gsz); u.pn = (wgid % nig) / gsz; return true;
}

__device__ __forceinline__ void gemm_epilogue(const f32x4 (&acc)[2][2][4][2], const GemmDesc& g, const Unit& u, int wr, int wc, int fr, int fq) {
  const int row0 = u.pm * BM + wr * 64 + fr;
  const int col0 = u.pn * BM + wc * 32 + 8 * fq;
  if (g.epi == EPI_F16) {
    float cs[2][8];
#pragma unroll
    for (int bj = 0; bj < 2; ++bj) {
      if (g.colscale) { const f32x4 a = *(const f32x4*)(g.colscale + col0 + bj * HALF), b = *(const f32x4*)(g.colscale + col0 + bj * HALF + 4);
        cs[bj][0] = a[0] * g.cscale; cs[bj][1] = a[1] * g.cscale; cs[bj][2] = a[2] * g.cscale; cs[bj][3] = a[3] * g.cscale;
        cs[bj][4] = b[0] * g.cscale; cs[bj][5] = b[1] * g.cscale; cs[bj][6] = b[2] * g.cscale; cs[bj][7] = b[3] * g.cscale;
      } else {
#pragma unroll
        for (int e = 0; e < 8; ++e) cs[bj][e] = g.cscale;
      }
    }
    const bool act = g.act != 0;
#pragma unroll
    for (int ai = 0; ai < 2; ++ai)
#pragma unroll
      for (int m = 0; m < 4; ++m) {
        f16* rowp = g.O + (size_t)(row0 + ai * HALF + m * 16) * g.ldc + col0;
#pragma unroll
        for (int bj = 0; bj < 2; ++bj) {
          f32x4 v0 = acc[ai][bj][m][0], v1 = acc[ai][bj][m][1];
          if (act) {
#pragma unroll
            for (int e = 0; e < 4; ++e) { float a = fmaxf(v0[e], 0.f); v0[e] = a * a; float b = fmaxf(v1[e], 0.f); v1[e] = b * b; }
          }
          u32x4 w;
          w.x = pk_f16(v0[0] * cs[bj][0], v0[1] * cs[bj][1]); w.y = pk_f16(v0[2] * cs[bj][2], v0[3] * cs[bj][3]);
          w.z = pk_f16(v1[0] * cs[bj][4], v1[1] * cs[bj][5]); w.w = pk_f16(v1[2] * cs[bj][6], v1[3] * cs[bj][7]);
          *(u32x4*)(rowp + bj * HALF) = w;
        }
      }
  } else {
    const int which = u.pn >> 2;
    const bool dorope = (which < 2) && (wc == 0);
    const float qs = (which == 0) ? g.cscale : 1.f;
    float ksum[2][8];
#pragma unroll
    for (int bj = 0; bj < 2; ++bj)
#pragma unroll
      for (int e = 0; e < 8; ++e) ksum[bj][e] = 0.f;
#pragma unroll
    for (int ai = 0; ai < 2; ++ai)
#pragma unroll
      for (int m = 0; m < 4; ++m) {
        const int row = row0 + ai * HALF + m * 16;
        f16* rowp = g.O + (size_t)row * g.ldc + col0;
        float cv[8], sv[8];
        if (dorope) {
          const float* rp = g.rope + (size_t)(row & (SEQ - 1)) * 16 + 8 * (fq & 1);
          const f32x4 c0 = *(const f32x4*)rp, c1 = *(const f32x4*)(rp + 4), s0 = *(const f32x4*)(rp + SEQ * 16), s1 = *(const f32x4*)(rp + SEQ * 16 + 4);
          const float sg = (fq < 2) ? -1.f : 1.f;
#pragma unroll
          for (int e = 0; e < 4; ++e) { cv[e] = c0[e]; cv[4 + e] = c1[e]; sv[e] = s0[e] * sg; sv[4 + e] = s1[e] * sg; }
        }
#pragma unroll
        for (int bj = 0; bj < 2; ++bj) {
          float v[8];
#pragma unroll
          for (int e = 0; e < 4; ++e) { v[e] = acc[ai][bj][m][0][e]; v[4 + e] = acc[ai][bj][m][1][e]; }
          if (dorope) {
#pragma unroll
            for (int e = 0; e < 8; ++e) { const float p = __shfl_xor(v[e], 32); v[e] = v[e] * cv[e] + p * sv[e]; }
          }
          if (which == 1) {
#pragma unroll
            for (int e = 0; e < 8; ++e) ksum[bj][e] += v[e];
          }
          u32x4 w;
          w.x = pk_f16(v[0] * qs, v[1] * qs); w.y = pk_f16(v[2] * qs, v[3] * qs); w.z = pk_f16(v[4] * qs, v[5] * qs); w.w = pk_f16(v[6] * qs, v[7] * qs);
          *(u32x4*)(rowp + bj * HALF) = w;
        }
      }
    if (which == 1 && g.kmean) {
      const int b = u.pm >> 3, blk = u.pm & 7;
#pragma unroll
      for (int bj = 0; bj < 2; ++bj) {
        const int head = 2 * (u.pn & 3) + bj;
        float* kp = g.kmean + ((size_t)((b * 8 + head) * 8 + blk)) * 128 + wc * 32 + 8 * fq;
#pragma unroll
        for (int e = 0; e < 8; ++e) {
          float s = ksum[bj][e];
          s += __shfl_xor(s, 1); s += __shfl_xor(s, 2); s += __shfl_xor(s, 4); s += __shfl_xor(s, 8);
          if (fr == 0) atomicAdd(kp + e, s);
        }
      }
    }
  }
}


__device__ __forceinline__ void panel_rstd(const f32x4 (&v)[2][2][4][2], const Unit& u, int wr, int wc, int fr, int fq, LAS unsigned char* lds, int wid, int lane,
                                           float* slots, unsigned* cnt, unsigned want) {
  LAS float* P = (LAS float*)lds; LAS float* S = (LAS float*)(lds + 4096);
#pragma unroll
  for (int ai = 0; ai < 2; ++ai)
#pragma unroll
    for (int m = 0; m < 4; ++m) {
      float q = 0.f;
#pragma unroll
      for (int bj = 0; bj < 2; ++bj)
#pragma unroll
        for (int n = 0; n < 2; ++n) { const f32x4 x = v[ai][bj][m][n]; q += (x[0] * x[0] + x[1] * x[1]) + (x[2] * x[2] + x[3] * x[3]); }
      q += __shfl_xor(q, 16); q += __shfl_xor(q, 32);
      if (fq == 0) P[(ai * HALF + wr * 64 + m * 16 + fr) * 4 + wc] = q;
    }
  asm volatile("s_waitcnt lgkmcnt(0)" ::: "memory"); __builtin_amdgcn_s_barrier(); asm volatile("" ::: "memory");
  const int row = wid * 32 + (lane & 31);
  if (lane < 32) {
    const f32x4 p = *(const LAS f32x4*)(P + row * 4);
    const float mine = (p[0] + p[1]) + (p[2] + p[3]);
    unsigned long long* sl = (unsigned long long*)slots + (size_t)(u.pm * BM + row) * 4;
    __hip_atomic_store(sl + u.pn, ((unsigned long long)want << 32) | __float_as_uint(mine), __ATOMIC_RELAXED, __HIP_MEMORY_SCOPE_AGENT);
    float t = 0.f;
#pragma unroll
    for (int k = 0; k < 4; ++k) {
      float val = mine;
      if (k != u.pn) {
        unsigned sp = 0;
        for (;;) {
          const unsigned long long w = __hip_atomic_load(sl + k, __ATOMIC_RELAXED, __HIP_MEMORY_SCOPE_AGENT);
          if ((unsigned)(w >> 32) == want) { val = __uint_as_float((unsigned)w); break; }
          if (++sp > (1u << 22)) break;
          __builtin_amdgcn_s_sleep(1);
        }
      }
      t += val;
    }
    S[row] = 1.0f / sqrtf(t * (1.0f / DM) + RMS_EPS);
  }
  asm volatile("s_waitcnt vmcnt(0) lgkmcnt(0)" ::: "memory"); __builtin_amdgcn_s_barrier(); asm volatile("" ::: "memory");
}
__device__ __forceinline__ void fused_epilogue(f32x4 (&acc)[2][2][4][2], const GemmDesc& g, const Unit& u, int wr, int wc, int fr, int fq, LAS unsigned char* lds, int wid, int lane) {
  const LAS float* S = (const LAS float*)(lds + 4096);
  const int col0 = u.pn * BM + wc * 32 + 8 * fq;
  if (g.colscale) {
#pragma unroll
    for (int bj = 0; bj < 2; ++bj) {
      const f32x4 c0 = *(const f32x4*)(g.colscale + col0 + bj * HALF), c1 = *(const f32x4*)(g.colscale + col0 + bj * HALF + 4);
#pragma unroll
      for (int ai = 0; ai < 2; ++ai)
#pragma unroll
        for (int m = 0; m < 4; ++m) { acc[ai][bj][m][0] = acc[ai][bj][m][0] * c0; acc[ai][bj][m][1] = acc[ai][bj][m][1] * c1; }
    }
  }
  f32x4 xpre[4][2][2];
#pragma unroll
  for (int m = 0; m < 4; ++m) { const float* xp = g.X + (size_t)(u.pm * BM + wr * 64 + m * 16 + fr) * DM + col0;
#pragma unroll
    for (int bj = 0; bj < 2; ++bj) { xpre[m][bj][0] = *(const f32x4*)(xp + bj * HALF); xpre[m][bj][1] = *(const f32x4*)(xp + bj * HALF + 4); } }
  panel_rstd(acc, u, wr, wc, fr, fq, lds, wid, lane, g.xslot, g.xcnt, g.want);
  {
    f32x4 ga[2][2];
#pragma unroll
    for (int bj = 0; bj < 2; ++bj) { ga[bj][0] = *(const f32x4*)(g.g1 + col0 + bj * HALF); ga[bj][1] = *(const f32x4*)(g.g1 + col0 + bj * HALF + 4); }
#pragma unroll
    for (int ai = 0; ai < 2; ++ai)
#pragma unroll
      for (int m = 0; m < 4; ++m) {
        const int r = ai * HALF + wr * 64 + m * 16 + fr; const float sr = S[r];
        const float* xp = g.X + (size_t)(u.pm * BM + r) * DM + col0;
#pragma unroll
        for (int bj = 0; bj < 2; ++bj) {
          const f32x4 x0 = ai == 0 ? xpre[m][bj][0] : *(const f32x4*)(xp + bj * HALF), x1 = ai == 0 ? xpre[m][bj][1] : *(const f32x4*)(xp + bj * HALF + 4);
          acc[ai][bj][m][0] = x0 + acc[ai][bj][m][0] * sr * ga[bj][0]; acc[ai][bj][m][1] = x1 + acc[ai][bj][m][1] * sr * ga[bj][1];
        }
      }
  }
  if (g.g2) {
    panel_rstd(acc, u, wr, wc, fr, fq, lds, wid, lane, g.xslot + (size_t)M * 8, g.xcnt + 64 * 64, g.want);
    f32x4 gb[2][2];
#pragma unroll
    for (int bj = 0; bj < 2; ++bj) { gb[bj][0] = *(const f32x4*)(g.g2 + col0 + bj * HALF); gb[bj][1] = *(const f32x4*)(g.g2 + col0 + bj * HALF + 4); }
#pragma unroll
    for (int ai = 0; ai < 2; ++ai)
#pragma unroll
      for (int m = 0; m < 4; ++m) {
        const int r = ai * HALF + wr * 64 + m * 16 + fr; const float sr = S[r];
        float* xp = g.X + (size_t)(u.pm * BM + r) * DM + col0;
        f16* hp = g.O + (size_t)(u.pm * BM + r) * DM + col0;
#pragma unroll
        for (int bj = 0; bj < 2; ++bj) {
          const f32x4 a0 = acc[ai][bj][m][0], a1 = acc[ai][bj][m][1];
          *(f32x4*)(xp + bj * HALF) = a0; *(f32x4*)(xp + bj * HALF + 4) = a1;
          const f32x4 h0 = a0 * sr * gb[bj][0], h1 = a1 * sr * gb[bj][1];
          u32x4 w; w.x = pk_f16(h0[0], h0[1]); w.y = pk_f16(h0[2], h0[3]); w.z = pk_f16(h1[0], h1[1]); w.w = pk_f16(h1[2], h1[3]);
          *(u32x4*)(hp + bj * HALF) = w;
        }
      }
  } else {
#pragma unroll
    for (int ai = 0; ai < 2; ++ai)
#pragma unroll
      for (int m = 0; m < 4; ++m) {
        const int r = ai * HALF + wr * 64 + m * 16 + fr;
        float* xp = g.X + (size_t)(u.pm * BM + r) * DM + col0;
#pragma unroll
        for (int bj = 0; bj < 2; ++bj) { *(f32x4*)(xp + bj * HALF) = acc[ai][bj][m][0]; *(f32x4*)(xp + bj * HALF + 4) = acc[ai][bj][m][1]; }
      }
  }
}

__device__ __forceinline__ void gemm_phase(LAS unsigned char* lds, const GemmDesc& g, int G, int c, const int tid) {
  const int wid = __builtin_amdgcn_readfirstlane(tid >> 6), lane = tid & 63, wr = wid >> 2, wc = wid & 3, fr = lane & 15, fq = lane >> 4;
  const int K = g.K, nt = K / BK;
  unsigned voffA[2], voffB[2];
#pragma unroll
  for (int i = 0; i < 2; ++i) { int R, C; stage_rc(tid * 16 + i * 8192, R, C); const int Rb = (R & ~31) + perm32(R & 31);
    voffA[i] = (unsigned)(R * g.lda + C) * 2u; voffB[i] = (unsigned)(Rb * g.ldb + C) * 2u; }
  const size_t kstep = (size_t)(BK * 2);
  const size_t hstepA = (size_t)HALF * g.lda * 2, hstepB = (size_t)HALF * g.ldb * 2;
  const size_t tstepA = 2 * hstepA, tstepB = 2 * hstepB;
  const unsigned ldsw = (unsigned)wid * 1024u;
  const int aoff = lds_byte(wr * 64 + fr, fq * 8), boff = lds_byte(wc * 32 + fr, fq * 8);
#define UA(u) ((size_t)(u).pm * tstepA + (g.mode == GM_GROUPED ? (size_t)(u).pn * 512 : 0))
#define UB(u) ((size_t)(g.mode == GM_KVM ? (((u).pm >> 3) * 8 + (u).pn) : (u).pn) * tstepB)
#define PG8_SA(b, h) (((b) * 2 + (h)) * HTB)
#define PG8_SB(b, h) ((4 + (b) * 2 + (h)) * HTB)
#define PG8_STAGE(bufoff, gbase, voff) do { _Pragma("unroll") for (int _i = 0; _i < 2; ++_i) \
    __builtin_amdgcn_global_load_lds((const unsigned*)((const char*)(gbase) + (voff)[_i]), (LAS unsigned*)(lds + (bufoff) + ldsw + _i * 8192), 16, 0, 0); } while (0)
#define PG8_LDA(dst, b, h) do { _Pragma("unroll") for (int m = 0; m < 4; ++m) _Pragma("unroll") for (int k = 0; k < 2; ++k) dst[m][k] = *(const LAS h8*)(lds + PG8_SA(b, h) + aoff + m * 2048 + k * 1024); } while (0)
#define PG8_LDB(dst, b, h) do { _Pragma("unroll") for (int n = 0; n < 2; ++n) _Pragma("unroll") for (int k = 0; k < 2; ++k) dst[n][k] = *(const LAS h8*)(lds + PG8_SB(b, h) + boff + n * 2048 + k * 1024); } while (0)
#define PG8_MMA(ai, bj, At, Bt) do { __builtin_amdgcn_s_setprio(1); _Pragma("unroll") for (int m = 0; m < 4; ++m) _Pragma("unroll") for (int n = 0; n < 2; ++n) _Pragma("unroll") for (int k = 0; k < 2; ++k) \
    acc[ai][bj][m][n] = __builtin_amdgcn_mfma_f32_16x16x32_f16(Bt[n][k], At[m][k], acc[ai][bj][m][n], 0, 0, 0); __builtin_amdgcn_s_setprio(0); } while (0)
#define PG8_WAIT_V(n) asm volatile("s_waitcnt vmcnt(" #n ")" ::: "memory")
#define PG8_WAIT_L(n) asm volatile("s_waitcnt lgkmcnt(" #n ")" ::: "memory")
#define PG8_BAR __builtin_amdgcn_s_barrier()
#define PG8_SCHED __builtin_amdgcn_sched_barrier(0)
  Unit cur, nxt; int ui = 0;
  if (!sched_next(g, G, c, 0, cur)) return;
  f32x4 acc[2][2][4][2];
#pragma unroll
  for (int a = 0; a < 2; ++a)
#pragma unroll
    for (int b = 0; b < 2; ++b)
#pragma unroll
      for (int m = 0; m < 4; ++m)
#pragma unroll
        for (int n = 0; n < 2; ++n) acc[a][b][m][n] = (f32x4){0.f, 0.f, 0.f, 0.f};
  h8 At[4][2], B0[2][2], B1[2][2];
  const char* cA = (const char*)g.A + UA(cur); const char* cB = (const char*)g.Bt + UB(cur);
  PG8_STAGE(PG8_SB(0, 0), cB, voffB); PG8_STAGE(PG8_SB(0, 1), cB + hstepB, voffB); PG8_STAGE(PG8_SA(0, 0), cA, voffA); PG8_STAGE(PG8_SA(0, 1), cA + hstepA, voffA);
  if (wr == 1) PG8_BAR;
  PG8_WAIT_V(2); PG8_BAR;
  PG8_STAGE(PG8_SB(1, 0), cB + kstep, voffB); PG8_STAGE(PG8_SA(1, 0), cA + kstep, voffA); PG8_STAGE(PG8_SB(1, 1), cB + hstepB + kstep, voffB);
  PG8_WAIT_V(6); PG8_BAR;
  for (;;) {
    const bool has_next = sched_next(g, G, c, ui + 1, nxt);
    const char* nA = has_next ? (const char*)g.A + UA(nxt) : cA; const char* nB = has_next ? (const char*)g.Bt + UB(nxt) : cB;
    for (int t = 0; t < nt; t += 2) {
      const bool last = (t == nt - 2);
      const char* a1 = cA + (size_t)(t + 1) * kstep;
      const char* a2 = last ? nA : cA + (size_t)(t + 2) * kstep; const char* b2 = last ? nB : cB + (size_t)(t + 2) * kstep;
      const char* a3 = a2 + kstep; const char* b3 = b2 + kstep;
      PG8_LDB(B0, 0, 0); PG8_LDB(B1, 0, 1); PG8_SCHED; PG8_LDA(At, 0, 0); PG8_STAGE(PG8_SA(1, 1), a1 + hstepA, voffA);
      PG8_WAIT_V(8); PG8_WAIT_L(0); PG8_BAR; PG8_MMA(0, 0, At, B0); PG8_MMA(0, 1, At, B1); PG8_BAR; PG8_SCHED;
      PG8_LDA(At, 0, 1); PG8_STAGE(PG8_SB(0, 0), b2, voffB); PG8_STAGE(PG8_SB(0, 1), b2 + hstepB, voffB); PG8_STAGE(PG8_SA(0, 0), a2, voffA);
      PG8_WAIT_V(8); PG8_WAIT_L(0); PG8_BAR; PG8_MMA(1, 0, At, B0); PG8_MMA(1, 1, At, B1); PG8_BAR; PG8_SCHED;
      PG8_LDB(B0, 1, 0); PG8_LDB(B1, 1, 1); PG8_SCHED; PG8_LDA(At, 1, 0); PG8_STAGE(PG8_SA(0, 1), a2 + hstepA, voffA);
      PG8_WAIT_V(8); PG8_WAIT_L(0); PG8_BAR; PG8_MMA(0, 0, At, B0); PG8_MMA(0, 1, At, B1); PG8_BAR; PG8_SCHED;
      PG8_LDA(At, 1, 1); PG8_STAGE(PG8_SB(1, 0), b3, voffB); PG8_STAGE(PG8_SB(1, 1), b3 + hstepB, voffB); PG8_STAGE(PG8_SA(1, 0), a3, voffA);
      PG8_WAIT_V(8); PG8_WAIT_L(0); PG8_BAR; PG8_MMA(1, 0, At, B0); PG8_MMA(1, 1, At, B1); PG8_BAR; PG8_SCHED;
    }
    if (wr == 0) PG8_BAR;
    if (!g.fuse) { int t2 = threadIdx.x; asm volatile("" : "+v"(t2)); gemm_epilogue(acc, g, cur, wr, wc, t2 & 15, (t2 & 63) >> 4); }
    if (!has_next) break;
#pragma unroll
    for (int a = 0; a < 2; ++a)
#pragma unroll
      for (int b = 0; b < 2; ++b)
#pragma unroll
        for (int m = 0; m < 4; ++m)
#pragma unroll
          for (int n = 0; n < 2; ++n) acc[a][b][m][n] = (f32x4){0.f, 0.f, 0.f, 0.f};
    cur = nxt; cA = nA; cB = nB; ++ui;
    if (wr == 1) PG8_BAR;
  }
  PG8_WAIT_V(0);
  PG8_BAR;
  if (g.fuse) { int t2 = threadIdx.x; asm volatile("" : "+v"(t2)); fused_epilogue(acc, g, cur, wr, wc, t2 & 15, (t2 & 63) >> 4, lds, wid, t2 & 63); }
#undef UA
#undef UB
#undef PG8_SA
#undef PG8_SB
#undef PG8_STAGE
#undef PG8_LDA
#undef PG8_LDB
#undef PG8_MMA
#undef PG8_WAIT_V
#undef PG8_WAIT_L
#undef PG8_BAR
#undef PG8_SCHED
}

__device__ __forceinline__ s16x4 vtr(const LAS unsigned char* p) { return __builtin_amdgcn_ds_read_tr16_b64_v4i16((LAS s16x4*)p); }

template <int HD, bool MOBA>
__device__ __forceinline__ void attn_unit(LAS unsigned char* lds, const f16* Qg, int ldq, const f16* Kg, const f16* Vg, int ldkv,
                                          f16* Og, int ldo, int qb, const float* kmg, const int tid) {
  constexpr int KS = HD * 2 + 16, VS = 320, KT_BYTES = 64 * KS, VT_BYTES = 64 * VS;
  constexpr int NSTEP = HD / 16, NPASS = HD / 128, KCH = HD / 8, KPT = 64 * KCH / 512, VPT = 2;
  constexpr int BUFB = KT_BYTES + VT_BYTES;
  LAS unsigned char* Kl = lds; LAS unsigned char* Vl = lds + KT_BYTES; LAS float* kml = (LAS float*)(lds + 2 * BUFB);
  const int lane = tid & 63, wid = __builtin_amdgcn_readfirstlane(tid >> 6), r32 = lane & 31, hi = lane >> 5;
  const float NEG = -INFINITY;
  constexpr bool QREG = true;
  constexpr int NQF = QREG ? NSTEP : 1;
  h8 qf[NQF];
  const f16* qrow = Qg + (size_t)(wid * 32 + r32) * ldq + hi * 8;
  if (QREG) {
#pragma unroll
    for (int s = 0; s < NQF; ++s) qf[s] = *(const h8*)(qrow + s * 16); }
  unsigned selmask = 0;
  if (MOBA && qb <= 3) selmask = (1u << qb) - 1u;
  if (MOBA && qb > 3) {
    for (int idx = tid; idx < qb * 128; idx += 512) kml[idx] = kmg[idx];
    __syncthreads();
    float gate[7];
#pragma unroll
    for (int j = 0; j < 7; ++j) {
      gate[j] = NEG;
      if (j < qb) {
        float a = 0.f;
#pragma unroll
        for (int s = 0; s < NSTEP; ++s) {
          const f32x4 k0 = *(const LAS f32x4*)(kml + j * 128 + s * 16 + hi * 8), k1 = *(const LAS f32x4*)(kml + j * 128 + s * 16 + hi * 8 + 4);
          a += (float)qf[s][0] * k0[0] + (float)qf[s][1] * k0[1] + (float)qf[s][2] * k0[2] + (float)qf[s][3] * k0[3]
             + (float)qf[s][4] * k1[0] + (float)qf[s][5] * k1[1] + (float)qf[s][6] * k1[2] + (float)qf[s][7] * k1[3];
        }
        a += __shfl_xor(a, 32);
        gate[j] = a;
      }
    }
    {
#pragma unroll
      for (int rnd = 0; rnd < 3; ++rnd) {
        float best = NEG; int bi = 0;
#pragma unroll
        for (int j = 0; j < 7; ++j) { const bool ok = (j < qb) && !((selmask >> j) & 1u) && (gate[j] > best); if (ok) { best = gate[j]; bi = j; } }
        selmask |= 1u << bi;
      }
    }
  }
  const int NT = MOBA ? 4 * (qb + 1) : 4;
  const LAS unsigned char* kb0 = Kl + r32 * KS + hi * 16;
  const LAS unsigned char* vb0 = Vl + (((lane & 15) >> 2) + 4 * hi) * VS + (16 * ((lane >> 4) & 1) + 4 * (lane & 3)) * 2;
#pragma unroll 1
  for (int pass = 0; pass < NPASS; ++pass) {
    f32x16 o[4];
#pragma unroll
    for (int d = 0; d < 4; ++d)
#pragma unroll
      for (int r = 0; r < 16; ++r) o[d][r] = 0.f;
    float m_run = NEG, l_run = 0.f;
    u32x4 kreg[KPT], vreg[VPT];
#define ATT_KEY0(t) (MOBA ? (((t) < 4 ? qb : (((t) - 4) >> 2)) * 256 + ((t) & 3) * 64) : (t) * 64)
#define ATT_LOAD(t) do { const int key0_ = ATT_KEY0(t); int tid_ = tid; asm volatile("" : "+v"(tid_)); \
      _Pragma("unroll") for (int i = 0; i < KPT; ++i) { const int id = tid_ + 512 * i, row = id / KCH, ch = id % KCH; kreg[i] = *(const u32x4*)(Kg + (size_t)(key0_ + row) * ldkv + ch * 8); } \
      _Pragma("unroll") for (int i = 0; i < VPT; ++i) { const int id = tid_ + 512 * i, row = id >> 4, ch = id & 15; vreg[i] = *(const u32x4*)(Vg + pass * 128 + (size_t)(key0_ + row) * ldkv + ch * 8); } } while (0)
#define ATT_STORE(bo) do { \
      _Pragma("unroll") for (int i = 0; i < KPT; ++i) { const int id = tid + 512 * i, row = id / KCH, ch = id % KCH; *(LAS u32x4*)(Kl + (bo) + row * KS + ch * 16) = kreg[i]; } \
      _Pragma("unroll") for (int i = 0; i < VPT; ++i) { const int id = tid + 512 * i, row = id >> 4, ch = id & 15; *(LAS u32x4*)(Vl + (bo) + row * VS + ch * 16) = vreg[i]; } } while (0)
    ATT_LOAD(0);
    ATT_STORE(0);
    if (NT > 1) ATT_LOAD(1);
    __syncthreads();
#define ATT_TILE(OWN_) do { \
      const int bo = (t & 1) * BUFB; \
      const LAS unsigned char* kb = kb0 + bo; const LAS unsigned char* vb = vb0 + bo; \
      const int blk = MOBA ? (OWN_ ? qb : ((t - 4) >> 2)) : 0, kt = t & 3; \
      const bool own = MOBA && OWN_; \
      const bool sel = own || !MOBA || (((selmask >> blk) & 1u) != 0u); \
      bool need = true; \
      if (MOBA) { if (own) need = (kt <= (wid >> 1)); else need = (__ballot((selmask >> blk) & 1u) != 0ull); } \
      if (need) { \
        f32x16 p0, p1; \
        const f32x16 zero16 = {0.f, 0.f, 0.f, 0.f, 0.f, 0.f, 0.f, 0.f, 0.f, 0.f, 0.f, 0.f, 0.f, 0.f, 0.f, 0.f}; \
        const f16* qr = qrow; if (!QREG) asm volatile("" : "+v"(qr)); \
      _Pragma("unroll") \
        for (int s = 0; s < NSTEP; ++s) { \
          const h8 k0 = *(const LAS h8*)(kb + s * 32), k1 = *(const LAS h8*)(kb + 32 * KS + s * 32); \
          const h8 q = QREG ? qf[QREG ? s : 0] : *(const h8*)(qr + s * 16); \
          p0 = __builtin_amdgcn_mfma_f32_32x32x16_f16(k0, q, s == 0 ? zero16 : p0, 0, 0, 0); \
          p1 = __builtin_amdgcn_mfma_f32_32x32x16_f16(k1, q, s == 0 ? zero16 : p1, 0, 0, 0); \
        } \
        if (MOBA && own) { \
          const int qpos = wid * 32 + r32, kbase = kt * 64 + 4 * hi; \
      _Pragma("unroll") \
          for (int r = 0; r < 16; ++r) { const int kv = kbase + (r & 3) + 8 * (r >> 2); if (kv > qpos) p0[r] = NEG; if (kv + 32 > qpos) p1[r] = NEG; } \
        } \
        float mx = fmaxf(p0[0], p1[0]); \
      _Pragma("unroll") \
        for (int r = 1; r < 16; ++r) mx = fmaxf(mx, fmaxf(p0[r], p1[r])); \
        mx = fmaxf(mx, __shfl_xor(mx, 32)); \
        if (!sel) mx = NEG; \
        const float m_new = fmaxf(m_run, mx); \
        const float alpha = __builtin_amdgcn_exp2f(m_run - m_new); \
        m_run = m_new; \
        float ps = 0.f; \
        const float m_sub = sel ? m_new : INFINITY; \
      _Pragma("unroll") \
        for (int r = 0; r < 16; ++r) { p0[r] = __builtin_amdgcn_exp2f(p0[r] - m_sub); p1[r] = __builtin_amdgcn_exp2f(p1[r] - m_sub); ps += p0[r] + p1[r]; } \
        l_run = l_run * alpha + ps; \
        if (__ballot(alpha != 1.0f) != 0ull) { \
      _Pragma("unroll") \
          for (int d = 0; d < 4; ++d) \
      _Pragma("unroll") \
            for (int r = 0; r < 16; ++r) o[d][r] *= alpha; \
        } \
        h8 pf[4]; \
        { u32x4 w; \
          w.x = pk_f16(p0[0], p0[1]); w.y = pk_f16(p0[2], p0[3]); w.z = pk_f16(p0[4], p0[5]); w.w = pk_f16(p0[6], p0[7]); pf[0] = __builtin_bit_cast(h8, w); \
          w.x = pk_f16(p0[8], p0[9]); w.y = pk_f16(p0[10], p0[11]); w.z = pk_f16(p0[12], p0[13]); w.w = pk_f16(p0[14], p0[15]); pf[1] = __builtin_bit_cast(h8, w); \
          w.x = pk_f16(p1[0], p1[1]); w.y = pk_f16(p1[2], p1[3]); w.z = pk_f16(p1[4], p1[5]); w.w = pk_f16(p1[6], p1[7]); pf[2] = __builtin_bit_cast(h8, w); \
          w.x = pk_f16(p1[8], p1[9]); w.y = pk_f16(p1[10], p1[11]); w.z = pk_f16(p1[12], p1[13]); w.w = pk_f16(p1[14], p1[15]); pf[3] = __builtin_bit_cast(h8, w); } \
      _Pragma("unroll") \
        for (int s = 0; s < 4; ++s) \
      _Pragma("unroll") \
          for (int d = 0; d < 4; ++d) { \
            const s16x4 lo = vtr(vb + (16 * s) * VS + d * 64), hh = vtr(vb + (16 * s + 8) * VS + d * 64); \
            typedef short s16x8 __attribute__((ext_vector_type(8))); \
            const s16x8 av = {lo[0], lo[1], lo[2], lo[3], hh[0], hh[1], hh[2], hh[3]}; \
            o[d] = __builtin_amdgcn_mfma_f32_32x32x16_f16(__builtin_bit_cast(h8, av), pf[s], o[d], 0, 0, 0); \
          } \
      } \
      if (t + 1 < NT) { ATT_STORE(BUFB - bo); if (t + 2 < NT) ATT_LOAD(t + 2); } \
      __syncthreads(); \
    } while (0)
    int t = 0;
#pragma unroll 1
    for (; t < NT && t < (MOBA ? 4 : NT); ++t) ATT_TILE(1);
#pragma unroll 1
    for (; t < NT; ++t) ATT_TILE(0);
#undef ATT_TILE
#undef ATT_LOAD
#undef ATT_STORE
#undef ATT_KEY0
    const float l = l_run + __shfl_xor(l_run, 32);
    const float inv = 1.0f / l;
    { LAS unsigned char* stg = lds + wid * 8192;
      int l1 = lane; asm volatile("" : "+v"(l1) :: "memory"); const int r1 = l1 & 31, h1 = l1 >> 5;
#pragma unroll
      for (int d = 0; d < 4; ++d)
#pragma unroll
        for (int rg = 0; rg < 4; ++rg) {
          u32x2 w; w.x = pk_f16(o[d][4 * rg] * inv, o[d][4 * rg + 1] * inv); w.y = pk_f16(o[d][4 * rg + 2] * inv, o[d][4 * rg + 3] * inv);
          *(LAS u32x2*)(stg + r1 * 256 + (((4 * d + rg) ^ (r1 & 15)) << 4) + h1 * 8) = w;
        }
      int l2 = lane; asm volatile("" : "+v"(l2) :: "memory");
      const int c2 = l2 & 15, h2 = l2 >> 4;
      f16* obase = Og + (size_t)(wid * 32) * ldo + pass * 128 + c2 * 8;
#pragma unroll
      for (int i = 0; i < 8; ++i) {
        const int q = 4 * i + h2;
        const u32x4 v = *(const LAS u32x4*)(stg + q * 256 + ((c2 ^ (q & 15)) << 4));
        *(u32x4*)(obase + (size_t)q * ldo) = v;
      }
    }
    __syncthreads();
  }
}


__device__ __forceinline__ void xatt_unit(LAS unsigned char* lds, const f16* Qg, const f16* Kg, const f16* Vg, f16* Og, const int tid) {
  constexpr int KS = 528, VS = 576, TB = 64 * VS, LDKV = 2048;
  const int lane = tid & 63, wid = __builtin_amdgcn_readfirstlane(tid >> 6), r32 = lane & 31, hi = lane >> 5;
  h8 qf[16];
  { const f16* qrow = Qg + (size_t)(wid * 32 + r32) * DM + hi * 8;
#pragma unroll
    for (int s = 0; s < 16; ++s) qf[s] = *(const h8*)(qrow + s * 16); }
  u32x4 kreg[4];
#define XLOAD(t) do { int tid_ = tid; asm volatile("" : "+v"(tid_)); const f16* base_ = ((t) < 4) ? Kg + (size_t)((t) * 64) * LDKV : Vg + (size_t)(((t) - 4) * 64) * LDKV; \
    _Pragma("unroll") for (int i = 0; i < 4; ++i) { const int id = tid_ + 512 * i, row = id >> 5, ch = id & 31; kreg[i] = *(const u32x4*)(base_ + (size_t)row * LDKV + ch * 8); } } while (0)
#define XSTORE(t, bo) do { int tid_ = tid; asm volatile("" : "+v"(tid_)); const int st_ = ((t) < 4) ? KS : VS; \
    _Pragma("unroll") for (int i = 0; i < 4; ++i) { const int id = tid_ + 512 * i, row = id >> 5, ch = id & 31; *(LAS u32x4*)(lds + (bo) + row * st_ + ch * 16) = kreg[i]; } } while (0)
  XLOAD(0); XSTORE(0, 0); XLOAD(1);
  __syncthreads();
  f32x16 p[8];
#pragma unroll
  for (int j = 0; j < 8; ++j)
#pragma unroll
    for (int r = 0; r < 16; ++r) p[j][r] = 0.f;
#pragma unroll
  for (int t = 0; t < 4; ++t) {
    const int bo = (t & 1) * TB;
    const LAS unsigned char* kb = lds + bo + r32 * KS + hi * 16;
#pragma unroll
    for (int s = 0; s < 16; ++s) {
      const h8 k0 = *(const LAS h8*)(kb + s * 32), k1 = *(const LAS h8*)(kb + 32 * KS + s * 32);
      p[2 * t] = __builtin_amdgcn_mfma_f32_32x32x16_f16(k0, qf[s], p[2 * t], 0, 0, 0);
      p[2 * t + 1] = __builtin_amdgcn_mfma_f32_32x32x16_f16(k1, qf[s], p[2 * t + 1], 0, 0, 0);
    }
    XSTORE(t + 1, TB - bo); XLOAD(t + 2);
    __syncthreads();
  }
  float mx = p[0][0];
#pragma unroll
  for (int j = 0; j < 8; ++j)
#pragma unroll
    for (int r = 0; r < 16; ++r) mx = fmaxf(mx, p[j][r]);
  mx = fmaxf(mx, __shfl_xor(mx, 32));
  float l = 0.f;
  h8 pf[16];
#pragma unroll
  for (int j = 0; j < 8; ++j) {
#pragma unroll
    for (int r = 0; r < 16; ++r) { p[j][r] = __builtin_amdgcn_exp2f(p[j][r] - mx); l += p[j][r]; }
    u32x4 w;
    w.x = pk_f16(p[j][0], p[j][1]); w.y = pk_f16(p[j][2], p[j][3]); w.z = pk_f16(p[j][4], p[j][5]); w.w = pk_f16(p[j][6], p[j][7]); pf[2 * j] = __builtin_bit_cast(h8, w);
    w.x = pk_f16(p[j][8], p[j][9]); w.y = pk_f16(p[j][10], p[j][11]); w.z = pk_f16(p[j][12], p[j][13]); w.w = pk_f16(p[j][14], p[j][15]); pf[2 * j + 1] = __builtin_bit_cast(h8, w);
  }
  l += __shfl_xor(l, 32);
  const float inv = 1.0f / l;
  f32x16 o[8];
#pragma unroll
  for (int d = 0; d < 8; ++d)
#pragma unroll
    for (int r = 0; r < 16; ++r) o[d][r] = 0.f;
#pragma unroll
  for (int t = 4; t < 8; ++t) {
    const int bo = (t & 1) * TB;
    const LAS unsigned char* vb = lds + bo + (((lane & 15) >> 2) + 4 * hi) * VS + (16 * ((lane >> 4) & 1) + 4 * (lane & 3)) * 2;
#pragma unroll
    for (int s = 0; s < 4; ++s)
#pragma unroll
      for (int d = 0; d < 8; ++d) {
        const s16x4 lo = vtr(vb + (16 * s) * VS + d * 64), hh = vtr(vb + (16 * s + 8) * VS + d * 64);
        typedef short s16x8 __attribute__((ext_vector_type(8)));
        const s16x8 av = {lo[0], lo[1], lo[2], lo[3], hh[0], hh[1], hh[2], hh[3]};
        o[d] = __builtin_amdgcn_mfma_f32_32x32x16_f16(__builtin_bit_cast(h8, av), pf[4 * (t - 4) + s], o[d], 0, 0, 0);
      }
    if (t + 1 < 8) XSTORE(t + 1, TB - bo);
    if (t + 2 < 8) XLOAD(t + 2);
    __syncthreads();
  }
#undef XLOAD
#undef XSTORE
  { LAS unsigned char* stg = lds + wid * 16384; int l1 = lane; asm volatile("" : "+v"(l1) :: "memory"); const int r1 = l1 & 31, h1 = l1 >> 5;
#pragma unroll
    for (int d = 0; d < 8; ++d) {
      asm volatile("" ::: "memory");
#pragma unroll
      for (int rg = 0; rg < 4; ++rg) {
        u32x2 w; w.x = pk_f16(o[d][4 * rg] * inv, o[d][4 * rg + 1] * inv); w.y = pk_f16(o[d][4 * rg + 2] * inv, o[d][4 * rg + 3] * inv);
        *(LAS u32x2*)(stg + r1 * 512 + (((4 * d + rg) ^ r1) << 4) + h1 * 8) = w;
      }
    }
    int l2 = lane; asm volatile("" : "+v"(l2) :: "memory");
    const int c2 = l2 & 31, h2 = l2 >> 5;
    f16* obase = Og + (size_t)(wid * 32) * DM + c2 * 8;
#pragma unroll
    for (int i = 0; i < 16; ++i) {
      const int q = 2 * i + h2;
      const u32x4 v = *(const LAS u32x4*)(stg + q * 512 + ((c2 ^ q) << 4));
      *(u32x4*)(obase + (size_t)q * DM) = v;
    }
  }
  __syncthreads();
}

#define XB_TMO      128
#define XB_XCNT(j)  (256  + 64 * (j))
#define XB_XSUB(j)  (1280 + 64 * (j))
#define XB_XGEN(j)  (2304 + 64 * (j))
#define XB_TOP      3328
#define XB_TOPGEN   3392
#define XCD_BAR_WORDS 3456
#define XB_SPIN_CAP (1u << 22)
__device__ __forceinline__ unsigned xb_ld(unsigned* p)              { return __hip_atomic_load(p, __ATOMIC_RELAXED, __HIP_MEMORY_SCOPE_AGENT); }
__device__ __forceinline__ unsigned xb_add(unsigned* p, unsigned v) { return __hip_atomic_fetch_add(p, v, __ATOMIC_RELAXED, __HIP_MEMORY_SCOPE_AGENT); }
__device__ __forceinline__ unsigned xb_xcc_id() { return (unsigned)__builtin_amdgcn_s_getreg((3 << 11) | 20) & 0xFu; }
#define XB_SPIN(cond, bar) do { unsigned _sp = 0; while (cond) { __builtin_amdgcn_s_sleep(1); \
    if ((++_sp & 255u) == 0u) { if (xb_ld(&(bar)[XB_TMO])) break; if (_sp > XB_SPIN_CAP) { atomicAdd(&(bar)[XB_TMO], 1u); break; } } } } while (0)
struct XcdBarrier { unsigned* bar; unsigned x; volatile LAS unsigned* st; };
__device__ __forceinline__ XcdBarrier xcd_barrier_post(unsigned* bar, volatile LAS unsigned* st) {
  XcdBarrier b; b.bar = bar; b.x = xb_xcc_id(); b.st = st;
  if (threadIdx.x == 0) (void)xb_add(&bar[XB_XCNT(b.x)], 1u);
  return b;
}
__device__ __forceinline__ void xcd_barrier_complete(unsigned* bar, unsigned x, unsigned& nloc, unsigned& nx) {
  const unsigned G = gridDim.x * gridDim.y * gridDim.z;
  unsigned sum, cnt, mine, sp = 0u;
  for (;;) {
    sum = 0u; cnt = 0u; mine = 0u;
#pragma unroll
    for (unsigned j = 0; j < 16; ++j) { const unsigned c = xb_ld(&bar[XB_XCNT(j)]); sum += c; cnt += (c > 0u) ? 1u : 0u; }
    mine = xb_ld(&bar[XB_XCNT(x)]);
    if (sum == G) break;
    __builtin_amdgcn_s_sleep(1);
    if ((++sp & 255u) == 0u) { if (xb_ld(&bar[XB_TMO])) break; if (sp > XB_SPIN_CAP) { atomicAdd(&bar[XB_TMO], 1u); break; } }
  }
  nloc = mine > 0u ? mine : 1u; nx = cnt > 0u ? cnt : 1u;
}
__device__ __forceinline__ void xcd_barrier(const XcdBarrier& b) {
  asm volatile("s_waitcnt vmcnt(0)" ::: "memory");
  __syncthreads();
  if (threadIdx.x == 0) {
    unsigned* bar = b.bar;
    unsigned nloc = b.st[0], nx = b.st[1];
    if (nloc == 0u) { xcd_barrier_complete(bar, b.x, nloc, nx); b.st[0] = nloc; b.st[1] = nx; }
    const unsigned k = b.st[2]; b.st[2] = k + 1u;
    const unsigned old = xb_add(&bar[XB_XSUB(b.x)], 1u);
    if (old + 1u == (k + 1u) * nloc) {
      __builtin_amdgcn_fence(__ATOMIC_RELEASE, "agent");
      asm volatile("s_waitcnt vmcnt(0)" ::: "memory");
      (void)xb_add(&bar[XB_TOP], 1u);
    }
    const unsigned target = (k + 1u) * nx;
    XB_SPIN(xb_ld(&bar[XB_TOP]) < target, bar);
    __builtin_amdgcn_fence(__ATOMIC_ACQUIRE, "agent");
    asm volatile("s_waitcnt vmcnt(0)" ::: "memory");
  }
  __syncthreads();
}

__device__ __forceinline__ void ew_phase(int vcu, int G, int wave, int lane, const float* xin, float* X, f16* R1, const float* gpost, const float* gpre) {
  f32x4 gp[4], gq[4];
#pragma unroll
  for (int j = 0; j < 4; ++j) { gp[j] = gpost ? *(const f32x4*)(gpost + lane * 4 + 256 * j) : (f32x4){0.f, 0.f, 0.f, 0.f}; gq[j] = gpre ? *(const f32x4*)(gpre + lane * 4 + 256 * j) : (f32x4){0.f, 0.f, 0.f, 0.f}; }
#pragma unroll 1
  for (int m = vcu * 8 + wave; m < M; m += G * 8) {
    const float* xr = (xin ? xin : X) + (size_t)m * DM + lane * 4;
    f16* rr = R1 + (size_t)m * DM + lane * 4;
    f32x4 xv[4];
#pragma unroll
    for (int j = 0; j < 4; ++j) xv[j] = *(const f32x4*)(xr + 256 * j);
    if (gpost) {
      f32x4 yv[4]; float ss = 0.f;
#pragma unroll
      for (int j = 0; j < 4; ++j) { const h4 y = *(const h4*)(rr + 256 * j); yv[j] = (f32x4){(float)y[0], (float)y[1], (float)y[2], (float)y[3]}; ss += yv[j][0] * yv[j][0] + yv[j][1] * yv[j][1] + yv[j][2] * yv[j][2] + yv[j][3] * yv[j][3]; }
      const float rstd = 1.0f / sqrtf(wave_sum(ss) * (1.0f / DM) + RMS_EPS);
#pragma unroll
      for (int j = 0; j < 4; ++j) xv[j] = xv[j] + yv[j] * rstd * gp[j];
    }
    float* xo = X + (size_t)m * DM + lane * 4;
#pragma unroll
    for (int j = 0; j < 4; ++j) *(f32x4*)(xo + 256 * j) = xv[j];
    if (gpre) {
      float ss = 0.f;
#pragma unroll
      for (int j = 0; j < 4; ++j) ss += xv[j][0] * xv[j][0] + xv[j][1] * xv[j][1] + xv[j][2] * xv[j][2] + xv[j][3] * xv[j][3];
      const float rstd = 1.0f / sqrtf(wave_sum(ss) * (1.0f / DM) + RMS_EPS);
#pragma unroll
      for (int j = 0; j < 4; ++j) { const f32x4 h = xv[j] * rstd * gq[j]; u32x2 w; w.x = pk_f16(h[0], h[1]); w.y = pk_f16(h[2], h[3]); *(u32x2*)(rr + 256 * j) = w; }
    }
  }
}

__device__ __forceinline__ void pool_phase(int vcu, int G, const f16* U, f16* P, const int tid, int tile_pm, int tile_pn) {
  const int id0 = tile_pm >= 0 ? ((tile_pm * 16 + (tid >> 5)) << 7) + tile_pn * 32 + (tid & 31) : vcu * 512 + tid;
  const int idstep = tile_pm >= 0 ? (M / 16) * 128 : G * 512;
#pragma unroll 1
  for (int id = id0; id < (M / 16) * 128; id += idstep) {
    const int chunk = id & 127, run = id >> 7, grp = chunk >> 5, w = 2 << grp;
    const int row0 = run * 16, t0 = row0 & (SEQ - 1);
    const f16* up = U + (size_t)row0 * DM + chunk * 8;
    f16* pp = P + (size_t)row0 * DM + chunk * 8;
    float sum[8];
#pragma unroll
    for (int e = 0; e < 8; ++e) sum[e] = 0.f;
    for (int k = 1; k < w; ++k) {
      if (t0 - k >= 0) { const h8 v = *(const h8*)(up - (size_t)k * DM);
#pragma unroll
        for (int e = 0; e < 8; ++e) sum[e] += (float)v[e]; }
    }
    for (int i = 0; i < 16; ++i) {
      const int t = t0 + i;
      const h8 cur = *(const h8*)(up + (size_t)i * DM);
      const float rc = 1.0f / (float)(t + 1 < w ? t + 1 : w);
      float o[8];
#pragma unroll
      for (int e = 0; e < 8; ++e) { sum[e] += (float)cur[e]; o[e] = sum[e] * rc - (float)cur[e]; }
      u32x4 wv; wv.x = pk_f16(o[0], o[1]); wv.y = pk_f16(o[2], o[3]); wv.z = pk_f16(o[4], o[5]); wv.w = pk_f16(o[6], o[7]);
      *(u32x4*)(pp + (size_t)i * DM) = wv;
      if (t - w + 1 >= 0) { const h8 old = *(const h8*)(up + (size_t)(i - w + 1) * DM);
#pragma unroll
        for (int e = 0; e < 8; ++e) sum[e] -= (float)old[e]; }
    }
  }
}

__device__ __forceinline__ void conv_matrix(const float* W, int K, int N, f16* WT, int ldk, int& off, int gw, int NGW, int lane, LAS unsigned char* stg) {
  const int nblk = N / 64, nitems = (K / 64) * nblk;
  int first = gw - (off % NGW); if (first < 0) first += NGW;
#pragma unroll 1
  for (int item = first; item < nitems; item += NGW) {
    const int kb = item / nblk, nb = item % nblk, k0 = 64 * kb, n0 = 64 * nb;
    const float* src = W + (size_t)k0 * N + n0 + lane;
    float v[64];
#pragma unroll
    for (int j = 0; j < 64; ++j) v[j] = __builtin_nontemporal_load(src + (size_t)j * N);
#pragma unroll
    for (int q = 0; q < 8; ++q) { u32x4 o; o.x = pk_f16(v[8 * q], v[8 * q + 1]); o.y = pk_f16(v[8 * q + 2], v[8 * q + 3]); o.z = pk_f16(v[8 * q + 4], v[8 * q + 5]); o.w = pk_f16(v[8 * q + 6], v[8 * q + 7]);
      *(LAS u32x4*)(stg + lane * 144 + q * 16) = o; }
    asm volatile("s_waitcnt lgkmcnt(0)" ::: "memory");
    f16* dst = WT + (size_t)(n0 + (lane >> 3)) * ldk + k0 + (lane & 7) * 8;
#pragma unroll
    for (int i = 0; i < 8; ++i) {
      const u32x4 o = *(const LAS u32x4*)(stg + (8 * i + (lane >> 3)) * 144 + (lane & 7) * 16);
      *(u32x4*)(dst + (size_t)(8 * i) * ldk) = o;
    }
    asm volatile("s_waitcnt lgkmcnt(0)" ::: "memory");
  }
  off += nitems;
}

__device__ const double INV_FREQ[16] = {
  1.0, 0.44036660267178046, 0.19392274474868576, 0.08539710028576561, 0.03760603093086393, 0.016560440080994446,
  0.007292664737217109, 0.003211445994752591, 0.001414213562373095, 0.000622772421914596, 0.0002742481756762073,
  0.00012076973741146504, 5.318295896944988e-05, 2.341999896140934e-05, 1.031338537721246e-05, 4.5416704806078695e-06 };

struct Args { const float* in[14]; float* out; unsigned char* ws; int ph_lo, ph_hi; };

__device__ __forceinline__ void conv_layer(const Args& a, int i, int& scr, int gw, int NGW, int lane, LAS unsigned char* stg) {
  unsigned char* wb = a.ws + WS_W; const int j = i >> 1;
  if ((i & 1) == 0) {
    conv_matrix(a.in[4] + (size_t)j * DM * DM, DM, DM, (f16*)(wb + WP_IN), DM, scr, gw, NGW, lane, stg);
    for (int g = 0; g < 4; ++g) conv_matrix(a.in[5] + (size_t)(j * 4 + g) * 65536, 256, 256, (f16*)(wb + WP_GRP) + g * 65536, 256, scr, gw, NGW, lane, stg);
    conv_matrix(a.in[9] + (size_t)i * DM * DM, DM, DM, (f16*)(wb + WP_XQ), DM, scr, gw, NGW, lane, stg);
    conv_matrix(a.in[11] + (size_t)i * DM * DM, DM, DM, (f16*)(wb + WP_XO), DM, scr, gw, NGW, lane, stg);
    conv_matrix(a.in[12] + (size_t)i * DM * DFF, DM, DFF, (f16*)(wb + WP_W1), DM, scr, gw, NGW, lane, stg);
    conv_matrix(a.in[13] + (size_t)i * DFF * DM, DFF, DM, (f16*)(wb + WP_W2), DFF, scr, gw, NGW, lane, stg);
  } else {
    conv_matrix(a.in[7] + (size_t)j * DM * 3 * DM, DM, 3 * DM, (f16*)(wb + WM_QKV), DM, scr, gw, NGW, lane, stg);
    conv_matrix(a.in[8] + (size_t)j * DM * DM, DM, DM, (f16*)(wb + WM_O), DM, scr, gw, NGW, lane, stg);
    conv_matrix(a.in[9] + (size_t)i * DM * DM, DM, DM, (f16*)(wb + WM_XQ), DM, scr, gw, NGW, lane, stg);
    conv_matrix(a.in[11] + (size_t)i * DM * DM, DM, DM, (f16*)(wb + WM_XO), DM, scr, gw, NGW, lane, stg);
    conv_matrix(a.in[12] + (size_t)i * DM * DFF, DM, DFF, (f16*)(wb + WM_W1), DM, scr, gw, NGW, lane, stg);
    conv_matrix(a.in[13] + (size_t)i * DFF * DM, DFF, DM, (f16*)(wb + WM_W2), DFF, scr, gw, NGW, lane, stg);
  }
}

constexpr int NPHASE = 2 + 11 * DEPTH;

__global__ void __launch_bounds__(512, 2) mega_fwd(Args a) {
  extern __shared__ __attribute__((aligned(16))) unsigned char lds_raw[];
  LAS unsigned char* lds = (LAS unsigned char*)lds_raw;
  const int G = gridDim.x, bx = blockIdx.x;
  const int vcu = (G % 8 == 0) ? (bx % 8) * (G / 8) + bx / 8 : bx;
  const int NGW = G * 8;

  volatile LAS unsigned* MISC = (volatile LAS unsigned*)(lds + 131072);
  if (threadIdx.x < 16) MISC[threadIdx.x] = 0u;
  __syncthreads();
  const XcdBarrier xbar = xcd_barrier_post((unsigned*)(a.ws + WS_BAR), MISC + 8);
  int nrun = 0;
#if TPROBE
  unsigned long long tacc = 0ull, t_end = __builtin_amdgcn_s_memrealtime();
#endif
#pragma unroll 1
  for (int ph = a.ph_lo; ph < a.ph_hi; ++ph) {
    unsigned long long wsi = (unsigned long long)a.ws; asm volatile("" : "+s"(wsi));
    unsigned char* ws = (unsigned char*)(__attribute__((address_space(1))) unsigned char*)wsi;
    float* X = a.out;
    f16* R1 = (f16*)(ws + WS_R1);
    f16* BIG = (f16*)(ws + WS_BIG);
    f16* KVM = (f16*)(ws + WS_KVM);
    float* KMEAN = (float*)(ws + WS_KMEAN);
    float* ROPE = (float*)(ws + WS_ROPE);
    const float* gains = a.in[2];
    int tid = threadIdx.x; asm volatile("" : "+v"(tid));
    const int lane = tid & 63, wave = __builtin_amdgcn_readfirstlane(tid >> 6), gw = vcu * 8 + wave;
    int scr = 0;
    LAS unsigned char* stg = lds + wave * 9216;
    enum { K_NONE, K_GEMM, K_EW, K_POOL, K_MOBA, K_XATT, K_PRO, K_CONV };
    int kind = K_NONE;
    GemmDesc g; g.A = nullptr; g.Bt = nullptr; g.lda = DM; g.ldb = DM; g.K = DM; g.nM = M / BM; g.nN = 4; g.mode = GM_NORMAL;
    g.epi = EPI_F16; g.act = 0; g.O = nullptr; g.ldc = DM; g.colscale = nullptr; g.cscale = 1.f; g.rope = ROPE; g.kmean = KMEAN;
    g.fuse = 0; g.want = 0; g.g1 = nullptr; g.g2 = nullptr; g.X = X; g.xslot = (float*)(ws + WS_XSLOT); g.xcnt = (unsigned*)(ws + WS_XCNT);
    const bool fuse = (G == 256);
    const float* ew_post = nullptr; const float* ew_pre = nullptr; int li = 0; bool conv23 = false; bool nobar = false;
    if (ph == 0) kind = K_PRO;
    else if (ph == 1) {
      kind = K_GEMM; g.A = BIG; g.Bt = BIG + 8 * MiB; g.nM = 32; g.nN = 8; g.mode = GM_KVM; g.O = KVM; g.ldc = 2048;
    } else {
      li = (ph - 2) / 11; const int s = (ph - 2) % 11; const bool moba = (li & 1) != 0;
      const f16* wl = (const f16*)(ws + WS_W);
      const float* gl = gains + (size_t)li * 6 * DM;
      switch (s) {
        case 0:
          kind = K_GEMM; g.A = R1;
          nobar = (ph == 2);
          if (!moba) { g.Bt = wl + WP_IN / 2; g.O = BIG + 32 * MiB; }
          else { g.Bt = wl + WM_QKV / 2; g.nN = 12; g.O = BIG; g.ldc = 3 * DM; g.epi = EPI_QKV; g.cscale = 0.08838834764831845f * LOG2E; g.kmean = KMEAN + (size_t)(li >> 1) * 65536; }
          break;
        case 1: kind = moba ? K_MOBA : K_POOL; break;
        case 2:
          kind = K_GEMM; g.O = R1;
          if (!moba) { g.A = BIG + 16 * MiB; g.Bt = wl + WP_GRP / 2; g.ldb = 256; g.K = 256; g.mode = GM_GROUPED; g.colscale = a.in[6] + (size_t)(li >> 1) * DM; nobar = fuse; }
          else { g.A = BIG + 48 * MiB; g.Bt = wl + WM_O / 2; }
          if (fuse) { g.fuse = 1; g.g1 = gl + 1 * DM; g.g2 = gl + 2 * DM; g.want = 32u * (unsigned)(li * 3 + 1); }
          break;
        case 3: kind = fuse ? K_NONE : K_EW; ew_post = gl + 1 * DM; ew_pre = gl + 2 * DM; break;
        case 4: kind = K_GEMM; g.A = R1; g.Bt = wl + (moba ? WM_XQ : WP_XQ) / 2; g.O = BIG; g.cscale = 0.0625f * LOG2E; break;
        case 5: kind = K_XATT; nobar = fuse; break;
        case 6: kind = K_GEMM; g.A = BIG + 16 * MiB; g.Bt = wl + (moba ? WM_XO : WP_XO) / 2; g.O = R1;
          if (fuse) { g.fuse = 1; g.g1 = gl + 3 * DM; g.g2 = gl + 4 * DM; g.want = 32u * (unsigned)(li * 3 + 2); }
          break;
        case 7: kind = fuse ? K_NONE : K_EW; ew_post = gl + 3 * DM; ew_pre = gl + 4 * DM; break;
        case 8: kind = K_GEMM; g.A = R1; g.Bt = wl + (moba ? WM_W1 : WP_W1) / 2; g.nN = 16; g.O = BIG; g.ldc = DFF; g.act = 1; break;
        case 9: kind = K_GEMM; g.A = BIG; g.lda = DFF; g.Bt = wl + (moba ? WM_W2 : WP_W2) / 2; g.ldb = DFF; g.K = DFF; g.O = R1;
          if (fuse) { g.fuse = 1; g.g1 = gl + 5 * DM; g.g2 = (li + 1 < DEPTH) ? gl + 6 * DM : nullptr; g.want = 32u * (unsigned)(li * 3 + 3); }
          break;
        default: conv23 = (li == 1); kind = fuse ? (conv23 ? K_CONV : K_NONE) : K_EW; ew_post = gl + 5 * DM; ew_pre = (li + 1 < DEPTH) ? gl + 6 * DM : nullptr; break;
      }
    }

    if (kind == K_NONE) continue;
    if (nrun > 0) {
      if (a.ph_lo < 0) cg::this_grid().sync();
      if (nobar) { asm volatile("s_waitcnt vmcnt(0)" ::: "memory"); __syncthreads(); }
      else { xcd_barrier(xbar);
#if PROBE == 3
        xcd_barrier(xbar); xcd_barrier(xbar);
#endif
      }
    }
    ++nrun;
#if TPROBE
    const unsigned long long t0 = __builtin_amdgcn_s_memrealtime();
    if (TPROBE == 1) tacc += t0 - t_end;
#endif
    if (kind == K_GEMM) {
#if PROBE == 1
#pragma unroll 1
      for (int rep = 0; rep < 2; ++rep) { gemm_phase(lds, g, G, bx, tid); __syncthreads(); g.kmean = nullptr; }
#else
      gemm_phase(lds, g, G, bx, tid);
#endif
    } else if (kind == K_EW) {
      ew_phase(vcu, G, wave, lane, nullptr, X, R1, ew_post, ew_pre);
#if PROBE == 4
      if (ew_pre) { __syncthreads(); ew_phase(vcu, G, wave, lane, nullptr, X, R1, nullptr, ew_pre); }
#endif
#if PROBE == 5
      for (int rep = 0; rep < 2; ++rep)
#endif
      if (conv23) { conv_layer(a, 2, scr, gw, NGW, lane, stg); conv_layer(a, 3, scr, gw, NGW, lane, stg); }
    } else if (kind == K_CONV) {
      conv_layer(a, 2, scr, gw, NGW, lane, stg); conv_layer(a, 3, scr, gw, NGW, lane, stg);
    } else if (kind == K_POOL) {
#if PROBE == 6
      for (int rep = 0; rep < 2; ++rep)
#endif
      { int tpm = -1, tpn = 0; if (fuse) { Unit up; (void)sched_next(g, G, bx, 0, up); tpm = up.pm; tpn = up.pn; }
        pool_phase(vcu, G, BIG + 32 * MiB, BIG + 16 * MiB, tid, tpm, tpn); }
    } else if (kind == K_MOBA) {
      const float* km = KMEAN + (size_t)(li >> 1) * 65536;
#if PROBE == 2
      for (int rep = 0; rep < 2; ++rep)
#endif
      for (int uid = vcu; uid < 512; uid += G) {
        const int bh = (uid & 255) >> 2, qb = (uid < 256) ? 7 - (uid & 3) : (uid & 3), b = bh >> 3, h = bh & 7;
        const f16* base = BIG + (size_t)b * SEQ * 3 * DM + h * 128;
        attn_unit<128, true>(lds, base + (size_t)qb * 256 * 3 * DM, 3 * DM, base + DM, base + 2 * DM, 3 * DM,
                             BIG + 48 * MiB + (size_t)(b * SEQ + qb * 256) * DM + h * 128, DM, qb, km + (size_t)bh * 8 * 128, tid);
      }
    } else if (kind == K_XATT) {
#if PROBE == 2
      for (int rep = 0; rep < 2; ++rep)
#endif
      for (int uid = vcu; uid < 256; uid += G) {
        int b = uid >> 5, h = (uid >> 3) & 3, qt = uid & 7;
        if (fuse) { Unit u; (void)sched_next(g, G, bx, 0, u); b = u.pm >> 3; qt = u.pm & 7; h = u.pn; }
        const f16* kv = KVM + (size_t)li * 2048 * 2048 + (size_t)b * NMEM * 2048 + h * 256;
        xatt_unit(lds, BIG + (size_t)(b * SEQ + qt * 256) * DM + h * 256, kv, kv + DM, BIG + 16 * MiB + (size_t)(b * SEQ + qt * 256) * DM + h * 256, tid);
      }
    } else if (kind == K_PRO) {
#if PROBE == 5
      for (int rep = 0; rep < 2; ++rep) {
#else
      {
#endif
      conv_layer(a, 0, scr, gw, NGW, lane, stg); conv_layer(a, 1, scr, gw, NGW, lane, stg);
      for (int i = 0; i < DEPTH; ++i) conv_matrix(a.in[10] + (size_t)i * DM * 2 * DM, DM, 2 * DM, BIG + 8 * MiB + (size_t)i * 2048 * DM, DM, scr, gw, NGW, lane, stg);
      }
#pragma unroll 1
      for (int r = gw; r < BATCH * NMEM; r += NGW) {
        const float* mr = a.in[1] + (size_t)r * DM + lane * 4; f32x4 v[4]; float ss = 0.f;
#pragma unroll
        for (int j = 0; j < 4; ++j) { v[j] = *(const f32x4*)(mr + 256 * j); ss += v[j][0] * v[j][0] + v[j][1] * v[j][1] + v[j][2] * v[j][2] + v[j][3] * v[j][3]; }
        const float rstd = 1.0f / sqrtf(wave_sum(ss) * (1.0f / DM) + RMS_EPS);
        for (int i = 0; i < DEPTH; ++i) {
          const float* gm = a.in[3] + (size_t)i * DM + lane * 4; f16* orow = BIG + ((size_t)i * 2048 + r) * DM + lane * 4;
#pragma unroll
          for (int j = 0; j < 4; ++j) { const f32x4 gg = *(const f32x4*)(gm + 256 * j); const f32x4 h = v[j] * rstd * gg; u32x2 w; w.x = pk_f16(h[0], h[1]); w.y = pk_f16(h[2], h[3]); *(u32x2*)(orow + 256 * j) = w; }
        }
      }
#pragma unroll 1
      for (int id = vcu * 512 + tid; id < SEQ * 16; id += G * 512) {
        const int pos = id >> 4, i = id & 15;
        const double rev = (double)pos * INV_FREQ[i] * 0.15915494309189535;
        const float fr = (float)(rev - (double)(long long)rev);
        ROPE[id] = __builtin_amdgcn_cosf(fr); ROPE[SEQ * 16 + id] = __builtin_amdgcn_sinf(fr); asm volatile("" : "+v"(id));
      }
      { float* xs = (float*)(ws + WS_XSLOT); for (int id = vcu * 512 + tid; id < 2 * M * 8; id += G * 512) { xs[id] = 0.f; asm volatile("" : "+v"(id)); } }
      for (int id = vcu * 512 + tid; id < 2 * 65536; id += G * 512) { KMEAN[id] = 0.f; asm volatile("" : "+v"(id)); }
      ew_phase(vcu, G, wave, lane, a.in[0], X, R1, nullptr, gains);
    }
    __syncthreads();
#if TPROBE
    { const unsigned long long t1 = __builtin_amdgcn_s_memrealtime(); t_end = t1;
      int cat = 5;
      if (kind == K_GEMM) { cat = 2; }
      else if (kind == K_MOBA) cat = 3; else if (kind == K_XATT) cat = 4;
      bool hit = (cat == TPROBE);
      if (kind == K_GEMM) {
        if (TPROBE == 6) hit = (g.K == DFF);
        if (TPROBE == 7) hit = (g.nN == 16);
        if (TPROBE == 8) hit = (g.nN == 12);
        if (TPROBE == 9) hit = (g.nN == 4 && g.K == DM && g.mode == GM_NORMAL);
        if (TPROBE == 10) hit = (g.mode == GM_GROUPED);
        if (TPROBE == 12) hit = (g.mode == GM_KVM);
      }
      if (TPROBE == 11) hit = (kind == K_PRO);
      if (TPROBE == 13) hit = (kind == K_CONV);
      if (TPROBE == 14) hit = (kind == K_POOL);
      if (hit) tacc += t1 - t0; }
#endif
  }
#if TPROBE
  if (bx == 0) { const unsigned long long ts = __builtin_amdgcn_s_memrealtime(); while (__builtin_amdgcn_s_memrealtime() - ts < 3ull * tacc) __builtin_amdgcn_s_sleep(8); }
#endif
}

extern "C" void kernel_launch(void* const* d_in, const int* in_sizes, int n_in, void* d_out, int out_size, void* d_ws, size_t ws_size, hipStream_t stream) {
  static int grid = 0;
  if (grid == 0) {
    int dev = 0, cus = 0, per_cu = 0;
    hipGetDevice(&dev);
    hipDeviceGetAttribute(&cus, hipDeviceAttributeMultiprocessorCount, dev);
    hipFuncSetAttribute((const void*)mega_fwd, hipFuncAttributeMaxDynamicSharedMemorySize, LDS_BYTES);
    hipOccupancyMaxActiveBlocksPerMultiprocessor(&per_cu, (const void*)mega_fwd, 512, LDS_BYTES);
    if (per_cu < 1) { fprintf(stderr, "occupancy query returned %d\n", per_cu); per_cu = 1; }
    (void)hipGetLastError();
    grid = cus;
    if (ws_size < WS_END) fprintf(stderr, "workspace too small: %zu\n", ws_size);
  }
  (void)hipMemsetAsync((char*)d_ws + WS_BAR, 0, 48 * 1024, stream);
  Args a{};
  for (int i = 0; i < 14; ++i) a.in[i] = (const float*)d_in[i];
  a.out = (float*)d_out; a.ws = (unsigned char*)d_ws;
#if MULTI_LAUNCH
  for (int ph = 0; ph < NPHASE; ++ph) { a.ph_lo = ph; a.ph_hi = ph + 1; hipLaunchKernelGGL(mega_fwd, dim3(grid), dim3(512), LDS_BYTES, stream, a); }
#else
  a.ph_lo = 0; a.ph_hi = NPHASE;
  void* args[] = {&a};
  hipError_t e = hipLaunchCooperativeKernel((const void*)mega_fwd, dim3(grid), dim3(512), args, LDS_BYTES, stream);
  if (e != hipSuccess) fprintf(stderr, "cooperative launch failed: %s (grid %d)\n", hipGetErrorString(e), grid);
#endif
}
```
